# Optimizing an MI355X kernel written in HIP

```python
import math
import jax, jax.numpy as jnp
from jax import lax
import numpy as np

D_MODEL = 1024
BATCH = 8
SEQ = 4096
DEPTH = 1

HGRN_EXPAND = 128
HGRN_HEADS = D_MODEL // HGRN_EXPAND
HGRN_DK = HGRN_EXPAND
HGRN_DV = D_MODEL // HGRN_HEADS
HGRN_K_WIDTH = HGRN_HEADS * HGRN_DK
HGRN_V_WIDTH = HGRN_HEADS * HGRN_DV
CHUNK = 64
CONV_CH = D_MODEL
CONV_K = 31
D_FF = 2816
FFN_RESIDUAL = 0.5
N_MOD = 9
EPS = 1e-6
IN_SIZES = (HGRN_K_WIDTH, HGRN_K_WIDTH, HGRN_V_WIDTH, HGRN_V_WIDTH, 2 * CONV_CH, D_MODEL, D_MODEL)
IN_WIDTH = sum(IN_SIZES)
IN_SPLITS = tuple(int(s) for s in np.cumsum(IN_SIZES)[:-1])

kernel_name = "hybrid_hgrn2_conformer_macaron_adaln"


def rms_norm(x, g):
    xf = x.astype(jnp.float32)
    y = xf * lax.rsqrt(jnp.mean(xf * xf, axis=-1, keepdims=True) + EPS)
    return (y * g.astype(jnp.float32)).astype(x.dtype)


def layer_norm(x, g, b):
    xf = x.astype(jnp.float32)
    mu = jnp.mean(xf, axis=-1, keepdims=True)
    xc = xf - mu
    y = xc * lax.rsqrt(jnp.mean(xc * xc, axis=-1, keepdims=True) + EPS)
    return (y * g.astype(jnp.float32) + b.astype(jnp.float32)).astype(x.dtype)


def swiglu(h, w_in, w_out):
    a, b = jnp.split(h @ w_in, 2, axis=-1)
    return (jax.nn.silu(a) * b) @ w_out


def hgrn2_chunked(q, k, v, logf):
    B, S, H, DK = q.shape
    DV = v.shape[-1]
    nc = S // CHUNK

    def to_chunks(t):
        return t.reshape(B, nc, CHUNK, H, t.shape[-1]).transpose(1, 0, 3, 2, 4)

    causal = jnp.tril(jnp.ones((CHUNK, CHUNK), dtype=bool))

    def step(state, inp):
        qc, kc, vc, gc = inp
        b = jnp.cumsum(gc, axis=-2)
        diff = b[:, :, :, None, :] - b[:, :, None, :, :]
        decay = jnp.exp(jnp.where(causal[:, :, None], diff, -jnp.inf))
        att = jnp.einsum('bhtd,bhsd,bhtsd->bhts', qc, kc, decay)
        o_intra = jnp.einsum('bhts,bhsv->bhtv', att, vc)
        o_inter = jnp.einsum('bhtd,bhdv->bhtv', qc * jnp.exp(b), state)
        b_last = b[:, :, -1, :]
        k_dec = kc * jnp.exp(b_last[:, :, None, :] - b)
        new_state = jnp.exp(b_last)[..., None] * state + jnp.einsum('bhsd,bhsv->bhdv', k_dec, vc)
        return new_state, o_intra + o_inter

    state0 = jnp.zeros((B, H, DK, DV), jnp.float32)
    _, o = lax.scan(step, state0, (to_chunks(q), to_chunks(k), to_chunks(v), to_chunks(logf)))
    return o.transpose(1, 0, 3, 2, 4).reshape(B, S, H, DV)


def causal_depthwise_conv(u, w, b):
    y = lax.conv_general_dilated(
        u, w[:, None, :].astype(u.dtype), window_strides=(1,), padding=[(CONV_K - 1, 0)],
        dimension_numbers=('NWC', 'WIO', 'NWC'), feature_group_count=u.shape[-1])
    return y + b


def token_mixer(h, lb, w_in, hgrn_g, hgrn_w_o, conv_w, conv_b, conv_ln_g, conv_ln_b, conv_w_o, w_out):
    B, S, _ = h.shape
    f32 = jnp.float32
    q, f, i, og, u, ga, gb = jnp.split(h @ w_in, IN_SPLITS, axis=-1)
    q = (jax.nn.silu(q.astype(f32)) * (HGRN_DK ** -0.5)).reshape(B, S, HGRN_HEADS, HGRN_DK)
    fg = lb + (1.0 - lb) * jax.nn.sigmoid(f.astype(f32))
    logf = jnp.log(fg).reshape(B, S, HGRN_HEADS, HGRN_DK)
    k = (1.0 - fg).reshape(B, S, HGRN_HEADS, HGRN_DK)
    v = i.astype(f32).reshape(B, S, HGRN_HEADS, HGRN_DV)
    o = hgrn2_chunked(q, k, v, logf)
    o = o * lax.rsqrt(jnp.mean(o * o, axis=-1, keepdims=True) + EPS)
    o = o * hgrn_g.astype(f32).reshape(HGRN_HEADS, HGRN_DV)
    o = (o.reshape(B, S, HGRN_V_WIDTH) * jax.nn.silu(og.astype(f32))).astype(h.dtype)
    y_a = o @ hgrn_w_o
    ua, ub = jnp.split(u, 2, axis=-1)
    u = ua * jax.nn.sigmoid(ub)
    u = causal_depthwise_conv(u, conv_w, conv_b)
    u = jax.nn.silu(layer_norm(u, conv_ln_g, conv_ln_b))
    y_b = u @ conv_w_o
    merged = jax.nn.sigmoid(ga) * y_a + jax.nn.sigmoid(gb) * y_b
    return merged @ w_out


def setup_inputs(seed: int = 0) -> dict:
    key = jax.random.key(seed)
    ks = jax.random.split(key, 24)
    D, L = D_MODEL, DEPTH
    nrm = lambda k, shape, fan_in: jax.random.normal(k, shape, jnp.float32) * (fan_in ** -0.5)
    gain = lambda k, shape: 1.0 + 0.02 * jax.random.normal(k, shape, jnp.float32)
    small = lambda k, shape: 0.02 * jax.random.normal(k, shape, jnp.float32)
    return {
        "x": jax.random.normal(ks[0], (BATCH, SEQ, D), jnp.float32),
        "c": jax.random.normal(ks[1], (BATCH, D), jnp.float32),
        "ada_w": nrm(ks[2], (L, D, N_MOD * D), D),
        "ada_b": small(ks[3], (L, N_MOD * D)),
        "norm_ffn1": gain(ks[4], (L, D)),
        "ffn1_w_in": nrm(ks[5], (L, D, 2 * D_FF), D),
        "ffn1_w_out": nrm(ks[6], (L, D_FF, D), D_FF),
        "norm_mix": gain(ks[7], (L, D)),
        "mix_w_in": nrm(ks[8], (L, D, IN_WIDTH), D),
        "hgrn_lb": 0.1 * jax.random.normal(ks[9], (L + 1, HGRN_K_WIDTH), jnp.float32),
        "hgrn_g": gain(ks[10], (L, HGRN_V_WIDTH)),
        "hgrn_w_o": nrm(ks[11], (L, HGRN_V_WIDTH, D), HGRN_V_WIDTH),
        "conv_w": nrm(ks[12], (L, CONV_K, CONV_CH), CONV_K),
        "conv_b": small(ks[13], (L, CONV_CH)),
        "conv_ln_g": gain(ks[14], (L, CONV_CH)),
        "conv_ln_b": small(ks[15], (L, CONV_CH)),
        "conv_w_o": nrm(ks[16], (L, CONV_CH, D), CONV_CH),
        "mix_w_out": nrm(ks[17], (L, D, D), D),
        "norm_ffn2": gain(ks[18], (L, D)),
        "ffn2_w_in": nrm(ks[19], (L, D, 2 * D_FF), D),
        "ffn2_w_out": nrm(ks[20], (L, D_FF, D), D_FF),
        "norm_final": gain(ks[21], (D,)),
    }


def reference(x, c, ada_w, ada_b, norm_ffn1, ffn1_w_in, ffn1_w_out, norm_mix, mix_w_in,
              hgrn_lb, hgrn_g, hgrn_w_o, conv_w, conv_b, conv_ln_g, conv_ln_b, conv_w_o,
              mix_w_out, norm_ffn2, ffn2_w_in, ffn2_w_out, norm_final):
    B = x.shape[0]
    lb_all = jnp.cumsum(jax.nn.softmax(hgrn_lb.astype(jnp.float32), axis=0), axis=0)
    cs = jax.nn.silu(c)
    for l in range(DEPTH):
        mod = (cs @ ada_w[l] + ada_b[l]).reshape(B, N_MOD, D_MODEL)
        sh1, sc1, g1, sh2, sc2, g2, sh3, sc3, g3 = [mod[:, j, None, :] for j in range(N_MOD)]
        h = rms_norm(x, norm_ffn1[l]) * (1.0 + sc1) + sh1
        x = x + FFN_RESIDUAL * g1 * swiglu(h, ffn1_w_in[l], ffn1_w_out[l])
        h = rms_norm(x, norm_mix[l]) * (1.0 + sc2) + sh2
        x = x + g2 * token_mixer(h, lb_all[l], mix_w_in[l], hgrn_g[l], hgrn_w_o[l], conv_w[l],
                                 conv_b[l], conv_ln_g[l], conv_ln_b[l], conv_w_o[l], mix_w_out[l])
        h = rms_norm(x, norm_ffn2[l]) * (1.0 + sc3) + sh3
        x = x + FFN_RESIDUAL * g3 * swiglu(h, ffn2_w_in[l], ffn2_w_out[l])
    return rms_norm(x, norm_final)
```

```cpp
#include <hip/hip_runtime.h>
#include <hip/hip_cooperative_groups.h>
#include <cstdio>
namespace cg = cooperative_groups;

#ifndef ONE_LAUNCH
#define ONE_LAUNCH 1
#endif
#ifndef DUP_PHASE
#define DUP_PHASE -1
#endif
#ifndef DBG_STOP
#define DBG_STOP 15
#endif
#ifndef DBG_DUMP
#define DBG_DUMP -1
#endif

#define LAS __attribute__((address_space(3)))
typedef unsigned short bf16_t;
typedef short bf16x8 __attribute__((ext_vector_type(8)));
typedef float f32x4 __attribute__((ext_vector_type(4)));
typedef float f32x2 __attribute__((ext_vector_type(2)));
typedef unsigned u32x4 __attribute__((ext_vector_type(4)));
typedef unsigned u32x2 __attribute__((ext_vector_type(2)));

constexpr int MTOK = 32768, DM = 1024, SEQ = 4096, DFF = 2816, NMOD = 9;
constexpr float EPS = 1e-6f;
constexpr int LDS_MAIN = 135168;
constexpr int LDS_BYTES = LDS_MAIN + 16;

constexpr size_t MiB = 1ull << 20;
constexpr size_t OFF_W1IN = 0;
constexpr size_t OFF_W1OUT = OFF_W1IN + 5632ull * 1024 * 2;
constexpr size_t OFF_WMIX = OFF_W1OUT + 1024ull * 2816 * 2;
constexpr size_t OFF_WHO = OFF_WMIX + 8192ull * 1024 * 2;
constexpr size_t OFF_WCO = OFF_WHO + 2 * MiB;
constexpr size_t OFF_WMO = OFF_WCO + 2 * MiB;
constexpr size_t OFF_W2IN = OFF_WMO + 2 * MiB;
constexpr size_t OFF_W2OUT = OFF_W2IN + 5632ull * 1024 * 2;
constexpr size_t OFF_MOD = 55 * MiB;
constexpr size_t OFF_LB = OFF_MOD + 512 * 1024;
constexpr size_t OFF_BAR = OFF_MOD + 768 * 1024;
constexpr size_t OFF_HBUF = 56 * MiB;
constexpr size_t OFF_R = 120 * MiB;
constexpr size_t SLOT = 64 * MiB;
constexpr size_t OFF_XRES = OFF_R + 5 * SLOT;
constexpr size_t WS_NEED = OFF_XRES + 64 * MiB;
static_assert(OFF_W2OUT + 1024ull * 2816 * 2 <= OFF_MOD, "weights overflow");

struct Args {
    const float* in[22];
    float* out;
    unsigned char* ws;
    int ph_lo, ph_hi;
    int coop, pad;
};

typedef __bf16 bf16x2_t __attribute__((ext_vector_type(2)));
__device__ __forceinline__ unsigned cvt_pk_bf16(float lo, float hi) { const f32x2 v = {lo, hi}; return __builtin_bit_cast(unsigned, __builtin_convertvector(v, bf16x2_t)); }
__device__ __forceinline__ bf16_t f2bf(float f) { return (bf16_t)(cvt_pk_bf16(f, 0.f) & 0xffffu); }
__device__ __forceinline__ float bf2f(bf16_t b) { return __uint_as_float(((unsigned)b) << 16); }
__device__ __forceinline__ float bflo(unsigned w) { return __uint_as_float(w << 16); }
__device__ __forceinline__ float bfhi(unsigned w) { return __uint_as_float(w & 0xffff0000u); }
__device__ __forceinline__ float fsigmoid(float x) { return __builtin_amdgcn_rcpf(1.0f + __expf(-x)); }
__device__ __forceinline__ float fsilu(float x) { return x * fsigmoid(x); }
__device__ __forceinline__ u32x4 pack8(const f32x4& a, const f32x4& b) {
    u32x4 w; w.x = cvt_pk_bf16(a[0], a[1]); w.y = cvt_pk_bf16(a[2], a[3]); w.z = cvt_pk_bf16(b[0], b[1]); w.w = cvt_pk_bf16(b[2], b[3]); return w;
}
__device__ __forceinline__ void unpack8(const u32x4& w, f32x4& a, f32x4& b) {
    a[0] = bflo(w.x); a[1] = bfhi(w.x); a[2] = bflo(w.y); a[3] = bfhi(w.y);
    b[0] = bflo(w.z); b[1] = bfhi(w.z); b[2] = bflo(w.w); b[3] = bfhi(w.w);
}

namespace pg8 {
constexpr int BM = 256, BK = 64, HALF = 128, HTB = HALF * BK * 2, STAGE_BYTES = 8 * HTB, NXCD = 8, WGM = 4;
__device__ __forceinline__ int lds_byte(int r, int c) { const int st = (r >> 4) * 2 + (c >> 5), rr = r & 15, cc = c & 31, ob = rr * 64 + cc * 2; return st * 1024 + (ob ^ (((ob >> 9) & 1) << 5)); }
__device__ __forceinline__ void stage_rc(int b, int& R, int& C) { const int st = b / 1024, sb = b % 1024, swz = sb ^ (((sb >> 9) & 1) << 5); R = (st >> 1) * 16 + swz / 64; C = (st & 1) * 32 + (swz % 64) / 2; }
__device__ __forceinline__ int perm32(int rho) { const int n = rho >> 4, i = rho & 15; return 8 * (i >> 2) + 4 * n + (i & 3); }
struct Unit { int pm, pn; };
struct Gemm { const bf16_t* A; const bf16_t* Bt; int M, N, K; };
struct StaticOrder {
    int nM, nN, nwg, G, c, base, cnt;
    __device__ void init(int M, int N, int G_, int c_, int base_, int cnt_) { nM = M / BM; nN = N / BM; nwg = nM * nN; G = G_; c = c_; base = base_; cnt = cnt_; }
    __device__ bool next(int i, Unit& u) const {
        if (i >= cnt) return false;
        const long L = (long)base + (long)i * G + c; if (L >= nwg) return false;
        int wgid = (int)L; { const int q = nwg / NXCD, r = nwg % NXCD, xcd = wgid % NXCD, off = wgid / NXCD; wgid = (xcd < r ? xcd * (q + 1) : r * (q + 1) + (xcd - r) * q) + off; }
        const int nig = WGM * nN, gid = wgid / nig, fm = gid * WGM, gsz = (nM - fm) < WGM ? (nM - fm) : WGM;
        u.pm = fm + ((wgid % nig) % gsz); u.pn = (wgid % nig) / gsz; return true;
    }
};

struct Split { int G, c, base, cnt; };
template <class Epi>
__device__ __forceinline__ void gemm_phase(LAS unsigned char* lds, const Gemm g, const Epi E, const Split sp) {
    const int tid = threadIdx.x, wid = __builtin_amdgcn_readfirstlane(tid >> 6), lane = tid & 63, wr = wid >> 2, wc = wid & 3, fr = lane & 15, fq = lane >> 4;
    const int K = g.K, nt = K / BK;
    StaticOrder S; S.init(g.M, g.N, sp.G, sp.c, sp.base, sp.cnt);
    unsigned voffA[2], voffB[2];
#pragma unroll
    for (int i = 0; i < 2; ++i) { int R, C; stage_rc(tid * 16 + i * 8192, R, C); const int Rb = Epi::PERM ? ((R & ~31) + perm32(R & 31)) : R;
        voffA[i] = (unsigned)(R * K + C) * 2u; voffB[i] = (unsigned)(Rb * K + C) * 2u; }
    const size_t kstep = (size_t)(BK * 2);
    const size_t hstep = (size_t)HALF * K * 2;
    const size_t tstep = 2 * hstep;
    const unsigned ldsw = (unsigned)wid * 1024u;
    const int aoff = lds_byte(wr * 64 + fr, fq * 8), boff = lds_byte(wc * 32 + fr, fq * 8);
#define PG8_SA(b, h) (((b) * 2 + (h)) * HTB)
#define PG8_SB(b, h) ((4 + (b) * 2 + (h)) * HTB)
#define PG8_STAGE(bufoff, gbase, voff) do { _Pragma("unroll") for (int _i = 0; _i < 2; ++_i) \
        __builtin_amdgcn_global_load_lds((const unsigned*)((const char*)(gbase) + (voff)[_i]), (LAS unsigned*)(lds + (bufoff) + ldsw + _i * 8192), 16, 0, 0); } while (0)
#define PG8_LDA(dst, b, h) do { _Pragma("unroll") for (int m = 0; m < 4; ++m) _Pragma("unroll") for (int k = 0; k < 2; ++k) dst[m][k] = *(const LAS bf16x8*)(lds + PG8_SA(b, h) + aoff + m * 2048 + k * 1024); } while (0)
#define PG8_LDB(dst, b, h) do { _Pragma("unroll") for (int n = 0; n < 2; ++n) _Pragma("unroll") for (int k = 0; k < 2; ++k) dst[n][k] = *(const LAS bf16x8*)(lds + PG8_SB(b, h) + boff + n * 2048 + k * 1024); } while (0)
#define PG8_MMA(ai, bj, At, Bt) do { __builtin_amdgcn_s_setprio(1); _Pragma("unroll") for (int m = 0; m < 4; ++m) _Pragma("unroll") for (int n = 0; n < 2; ++n) _Pragma("unroll") for (int k = 0; k < 2; ++k) \
        acc[ai][bj][m][n] = __builtin_amdgcn_mfma_f32_16x16x32_bf16(Bt[n][k], At[m][k], acc[ai][bj][m][n], 0, 0, 0); __builtin_amdgcn_s_setprio(0); } while (0)
#define PG8_WAIT_V(n) asm volatile("s_waitcnt vmcnt(" #n ")" ::: "memory")
#define PG8_WAIT_L(n) asm volatile("s_waitcnt lgkmcnt(" #n ")" ::: "memory")
#define PG8_BAR __builtin_amdgcn_s_barrier()
#define PG8_SCHED __builtin_amdgcn_sched_barrier(0)
    Unit cur, nxt; int ui = 0;
    if (!S.next(0, cur)) return;
    f32x4 acc[2][2][4][2];
#pragma unroll
    for (int a = 0; a < 2; ++a)
#pragma unroll
        for (int b = 0; b < 2; ++b)
#pragma unroll
            for (int m = 0; m < 4; ++m)
#pragma unroll
                for (int n = 0; n < 2; ++n) acc[a][b][m][n] = (f32x4){0.f, 0.f, 0.f, 0.f};
    bf16x8 At[4][2], B0[2][2], B1[2][2];
    const char* cA = (const char*)g.A + (size_t)cur.pm * tstep; const char* cB = (const char*)g.Bt + (size_t)cur.pn * tstep;
    PG8_STAGE(PG8_SB(0, 0), cB, voffB); PG8_STAGE(PG8_SA(0, 0), cA, voffA); PG8_STAGE(PG8_SB(0, 1), cB + hstep, voffB); PG8_STAGE(PG8_SA(0, 1), cA + hstep, voffA);
    if (wr == 1) PG8_BAR;
    PG8_WAIT_V(4); PG8_BAR;
    PG8_STAGE(PG8_SB(1, 0), cB + kstep, voffB); PG8_STAGE(PG8_SA(1, 0), cA + kstep, voffA); PG8_STAGE(PG8_SB(1, 1), cB + hstep + kstep, voffB);
    PG8_WAIT_V(6); PG8_BAR;
    for (;;) {
        const bool has_next = S.next(ui + 1, nxt);
        const char* nA = has_next ? (const char*)g.A + (size_t)nxt.pm * tstep : cA; const char* nB = has_next ? (const char*)g.Bt + (size_t)nxt.pn * tstep : cB;
        for (int t = 0; t < nt; t += 2) {
            const bool last = (t == nt - 2);
            const char* a1 = cA + (size_t)(t + 1) * kstep;
            const char* a2 = last ? nA : cA + (size_t)(t + 2) * kstep; const char* b2 = last ? nB : cB + (size_t)(t + 2) * kstep;
            const char* a3 = a2 + kstep; const char* b3 = b2 + kstep;
            PG8_LDB(B0, 0, 0); PG8_SCHED; PG8_LDA(At, 0, 0); PG8_STAGE(PG8_SA(1, 1), a1 + hstep, voffA);
            PG8_WAIT_L(8); PG8_BAR; PG8_WAIT_L(0); PG8_MMA(0, 0, At, B0); PG8_BAR; PG8_SCHED;
            PG8_LDB(B1, 0, 1); PG8_STAGE(PG8_SB(0, 0), b2, voffB);
            PG8_BAR; PG8_WAIT_L(0); PG8_MMA(0, 1, At, B1); PG8_BAR;
            PG8_LDA(At, 0, 1); PG8_STAGE(PG8_SA(0, 0), a2, voffA);
            PG8_BAR; PG8_WAIT_L(0); PG8_MMA(1, 0, At, B0); PG8_BAR; PG8_SCHED;
            PG8_STAGE(PG8_SB(0, 1), b2 + hstep, voffB);
            PG8_WAIT_V(6); PG8_BAR; PG8_MMA(1, 1, At, B1); PG8_BAR;
            PG8_LDB(B0, 1, 0); PG8_SCHED; PG8_LDA(At, 1, 0); PG8_STAGE(PG8_SA(0, 1), a2 + hstep, voffA);
            PG8_WAIT_L(8); PG8_BAR; PG8_WAIT_L(0); PG8_MMA(0, 0, At, B0); PG8_BAR; PG8_SCHED;
            PG8_LDB(B1, 1, 1); PG8_STAGE(PG8_SB(1, 0), b3, voffB);
            PG8_BAR; PG8_WAIT_L(0); PG8_MMA(0, 1, At, B1); PG8_BAR;
            PG8_LDA(At, 1, 1); PG8_STAGE(PG8_SA(1, 0), a3, voffA);
            PG8_BAR; PG8_WAIT_L(0); PG8_MMA(1, 0, At, B0); PG8_BAR; PG8_SCHED;
            PG8_STAGE(PG8_SB(1, 1), b3 + hstep, voffB);
            PG8_WAIT_V(6); PG8_BAR; PG8_MMA(1, 1, At, B1); PG8_BAR;
        }
        E(acc, cur, wr, wc, fr, fq);
        if (!has_next) break;
#pragma unroll
        for (int a = 0; a < 2; ++a)
#pragma unroll
            for (int b = 0; b < 2; ++b)
#pragma unroll
                for (int m = 0; m < 4; ++m)
#pragma unroll
                    for (int n = 0; n < 2; ++n) acc[a][b][m][n] = (f32x4){0.f, 0.f, 0.f, 0.f};
        cur = nxt; cA = nA; cB = nB; ++ui;
    }
    PG8_WAIT_V(0);
    if (wr == 0) PG8_BAR;
    PG8_BAR;
#undef PG8_SA
#undef PG8_SB
#undef PG8_STAGE
#undef PG8_LDA
#undef PG8_LDB
#undef PG8_MMA
#undef PG8_WAIT_V
#undef PG8_WAIT_L
#undef PG8_BAR
#undef PG8_SCHED
}
template <class Epi>
__device__ __forceinline__ void gemm_phase(LAS unsigned char* lds, const Gemm g, const Epi E) { gemm_phase(lds, g, E, Split{(int)gridDim.x, (int)blockIdx.x, 0, 1 << 30}); }
}
using pg8::Unit;
typedef f32x4 AccT[2][2][4][2];

struct EpiSwiGLU {
    static constexpr bool PERM = true;
    bf16_t* O; int ldo;
    __device__ __forceinline__ void operator()(const AccT& acc, const Unit& u, int wr, int wc, int fr, int fq) const {
        const int row0 = u.pm * 256 + wr * 64 + fr, col0 = u.pn * 128 + wc * 32 + 8 * fq;
#pragma unroll
        for (int ai = 0; ai < 2; ++ai)
#pragma unroll
            for (int m = 0; m < 4; ++m) {
                f32x4 v0, v1;
#pragma unroll
                for (int j = 0; j < 4; ++j) { v0[j] = fsilu(acc[ai][0][m][0][j]) * acc[ai][1][m][0][j]; v1[j] = fsilu(acc[ai][0][m][1][j]) * acc[ai][1][m][1][j]; }
                *(u32x4*)(O + (size_t)(row0 + ai * 128 + m * 16) * ldo + col0) = pack8(v0, v1);
            }
    }
};
struct EpiResid {
    static constexpr bool PERM = false;
    const float* base; float* out; const float* gate; float scale;
    __device__ __forceinline__ void operator()(const AccT& acc, const Unit& u, int wr, int wc, int fr, int fq) const {
        const int row0 = u.pm * 256 + wr * 64 + fr, col0 = u.pn * 256 + wc * 32 + 4 * fq;
        const float* gp = gate + (size_t)(u.pm >> 4) * (NMOD * DM) + col0;
        f32x4 gv[2][2];
#pragma unroll
        for (int bj = 0; bj < 2; ++bj)
#pragma unroll
            for (int n = 0; n < 2; ++n) gv[bj][n] = *(const f32x4*)(gp + bj * 128 + n * 16) * scale;
#pragma unroll
        for (int ai = 0; ai < 2; ++ai)
#pragma unroll
            for (int m = 0; m < 4; ++m) { const size_t off = (size_t)(row0 + ai * 128 + m * 16) * DM + col0;
#pragma unroll
                for (int bj = 0; bj < 2; ++bj)
#pragma unroll
                    for (int n = 0; n < 2; ++n) { const f32x4 bs = *(const f32x4*)(base + off + bj * 128 + n * 16); *(f32x4*)(out + off + bj * 128 + n * 16) = bs + gv[bj][n] * acc[ai][bj][m][n]; }
            }
    }
};
template <int HALFSTEP, int FIRST> struct EpiResidB {
    static constexpr bool PERM = true;
    static constexpr float scale = HALFSTEP ? 0.5f : 1.0f;
    const float* xin; bf16_t* xs; const float* gate;
    __device__ __forceinline__ void operator()(const AccT& acc, const Unit& u, int wr, int wc, int fr, int fq) const {
        const int row0 = u.pm * 256 + wr * 64 + fr, col0 = u.pn * 256 + wc * 32 + 8 * fq;
        const float* gp = gate + (size_t)(u.pm >> 4) * (NMOD * DM) + col0;
#pragma unroll
        for (int bj = 0; bj < 2; ++bj) {
            const f32x4 g0 = *(const f32x4*)(gp + bj * 128) * scale, g1 = *(const f32x4*)(gp + bj * 128 + 4) * scale;
#pragma unroll
            for (int ai = 0; ai < 2; ++ai)
#pragma unroll
                for (int m = 0; m < 4; ++m) { const size_t off = (size_t)(row0 + ai * 128 + m * 16) * DM + col0 + bj * 128;
                    f32x4 b0, b1;
                    if (FIRST) { b0 = *(const f32x4*)(xin + off); b1 = *(const f32x4*)(xin + off + 4); } else unpack8(*(const u32x4*)(xs + off), b0, b1);
                    *(u32x4*)(xs + off) = pack8(b0 + g0 * acc[ai][bj][m][0], b1 + g1 * acc[ai][bj][m][1]); }
        }
    }
};
struct EpiStore {
    static constexpr bool PERM = true;
    bf16_t* D;
    __device__ __forceinline__ void operator()(const AccT& acc, const Unit& u, int wr, int wc, int fr, int fq) const {
        const int row0 = u.pm * 256 + wr * 64 + fr, col0 = u.pn * 256 + wc * 32 + 8 * fq;
#pragma unroll
        for (int ai = 0; ai < 2; ++ai)
#pragma unroll
            for (int m = 0; m < 4; ++m)
#pragma unroll
                for (int bj = 0; bj < 2; ++bj) *(u32x4*)(D + (size_t)(row0 + ai * 128 + m * 16) * DM + col0 + bj * 128) = pack8(acc[ai][bj][m][0], acc[ai][bj][m][1]);
    }
};
struct EpiMixA {
    static constexpr bool PERM = true;
    bf16_t* P; const float* oml;
    template <int SEC> __device__ __forceinline__ void body(const AccT& acc, const Unit& u, int wr, int wc, int fr, int fq) const {
        const int row0 = u.pm * 256 + wr * 64 + fr, col0 = (u.pn & 3) * 256 + wc * 32 + 8 * fq;
        bf16_t* base = P + (size_t)SEC * (SLOT / 2);
#pragma unroll
        for (int bj = 0; bj < 2; ++bj) {
            f32x4 l0 = (f32x4){0.f, 0.f, 0.f, 0.f}, l1 = l0;
            if (SEC == 1) { l0 = *(const f32x4*)(oml + col0 + bj * 128); l1 = *(const f32x4*)(oml + col0 + bj * 128 + 4); }
#pragma unroll
            for (int ai = 0; ai < 2; ++ai)
#pragma unroll
                for (int m = 0; m < 4; ++m) {
                    f32x4 v0 = acc[ai][bj][m][0], v1 = acc[ai][bj][m][1];
                    if (SEC == 0) {
#pragma unroll
                        for (int j = 0; j < 4; ++j) { v0[j] = fsilu(v0[j]) * 0.08838834764831845f; v1[j] = fsilu(v1[j]) * 0.08838834764831845f; }
                    } else if (SEC == 3) {
#pragma unroll
                        for (int j = 0; j < 4; ++j) { v0[j] = fsilu(v0[j]); v1[j] = fsilu(v1[j]); }
                    } else if (SEC == 1) {
#pragma unroll
                        for (int j = 0; j < 4; ++j) { v0[j] = l0[j] * fsigmoid(-v0[j]); v1[j] = l1[j] * fsigmoid(-v1[j]); }
                    }
                    *(u32x4*)(base + (size_t)(row0 + ai * 128 + m * 16) * DM + col0 + bj * 128) = pack8(v0, v1);
                }
        }
    }
    __device__ __forceinline__ void operator()(const AccT& acc, const Unit& u, int wr, int wc, int fr, int fq) const {
        const int sec = u.pn >> 2;
        if (sec == 0) body<0>(acc, u, wr, wc, fr, fq); else if (sec == 1) body<1>(acc, u, wr, wc, fr, fq); else if (sec == 2) body<2>(acc, u, wr, wc, fr, fq); else body<3>(acc, u, wr, wc, fr, fq);
    }
};
struct EpiMixB {
    static constexpr bool PERM = true;
    bf16_t* ug; bf16_t* sga; bf16_t* sgb;
    __device__ __forceinline__ void operator()(const AccT& acc, const Unit& u, int wr, int wc, int fr, int fq) const {
        const int pn = u.pn; const int row0 = u.pm * 256 + wr * 64 + fr;
        if (pn < 8) {
            const int col0 = pn * 128 + wc * 32 + 8 * fq;
#pragma unroll
            for (int ai = 0; ai < 2; ++ai)
#pragma unroll
                for (int m = 0; m < 4; ++m) {
                    f32x4 v0, v1;
#pragma unroll
                    for (int j = 0; j < 4; ++j) { v0[j] = acc[ai][0][m][0][j] * fsigmoid(acc[ai][1][m][0][j]); v1[j] = acc[ai][0][m][1][j] * fsigmoid(acc[ai][1][m][1][j]); }
                    *(u32x4*)(ug + (size_t)(row0 + ai * 128 + m * 16) * DM + col0) = pack8(v0, v1);
                }
        } else {
            bf16_t* base = pn < 12 ? sga : sgb; const int col0 = (pn & 3) * 256 + wc * 32 + 8 * fq;
#pragma unroll
            for (int ai = 0; ai < 2; ++ai)
#pragma unroll
                for (int m = 0; m < 4; ++m)
#pragma unroll
                    for (int bj = 0; bj < 2; ++bj) {
                        f32x4 v0 = acc[ai][bj][m][0], v1 = acc[ai][bj][m][1];
#pragma unroll
                        for (int j = 0; j < 4; ++j) { v0[j] = fsigmoid(v0[j]); v1[j] = fsigmoid(v1[j]); }
                        *(u32x4*)(base + (size_t)(row0 + ai * 128 + m * 16) * DM + col0 + bj * 128) = pack8(v0, v1);
                    }
        }
    }
};
template <int MODE> struct EpiGate {
    static constexpr bool PERM = true;
    bf16_t* G; const bf16_t* Mprev;
    __device__ __forceinline__ void operator()(const AccT& acc, const Unit& u, int wr, int wc, int fr, int fq) const {
        const int row0 = u.pm * 256 + wr * 64 + fr, col0 = u.pn * 256 + wc * 32 + 8 * fq;
#pragma unroll
        for (int ai = 0; ai < 2; ++ai)
#pragma unroll
            for (int m = 0; m < 4; ++m)
#pragma unroll
                for (int bj = 0; bj < 2; ++bj) {
                    const size_t off = (size_t)(row0 + ai * 128 + m * 16) * DM + col0 + bj * 128;
                    f32x4 g0, g1; unpack8(*(const u32x4*)(G + off), g0, g1);
                    f32x4 v0 = g0 * acc[ai][bj][m][0], v1 = g1 * acc[ai][bj][m][1];
                    if (MODE == 1) { f32x4 p0, p1; unpack8(*(const u32x4*)(Mprev + off), p0, p1); v0 += p0; v1 += p1; }
                    *(u32x4*)(G + off) = pack8(v0, v1);
                }
    }
};

__device__ __forceinline__ int wcol_map(int n, int mode) {
    if (mode == 1) { const int j = n >> 8, r = n & 255; return r < 128 ? 128 * j + r : DFF + 128 * j + (r - 128); }
    if (mode == 2 && n >= 4096 && n < 6144) { const int q = n - 4096, j = q >> 8, r = q & 255; return r < 128 ? 4096 + 128 * j + r : 5120 + 128 * j + (r - 128); }
    return n;
}
__device__ void conv_weight(LAS unsigned char* lds, const float* src, bf16_t* dst, int K, int N, int mode) {
    LAS float* tile = (LAS float*)lds;
    const int tid = threadIdx.x; const int nkt = K >> 6, nnt = N >> 6, ntiles = nkt * nnt;
    const int r = tid >> 4, c4 = (tid & 15) * 4;
    int t = blockIdx.x; f32x4 v0 = (f32x4){0.f, 0.f, 0.f, 0.f}, v1 = v0;
    if (t < ntiles) { const int k0 = (t % nkt) * 64, sc0 = wcol_map((t / nkt) * 64, mode);
        v0 = *(const f32x4*)(src + (size_t)(k0 + r) * N + sc0 + c4); v1 = *(const f32x4*)(src + (size_t)(k0 + r + 32) * N + sc0 + c4); }
    while (t < ntiles) {
        const int k0 = (t % nkt) * 64, n0 = (t / nkt) * 64; const int tn = t + (int)gridDim.x;
        f32x4 p0 = v0, p1 = v1;
        if (tn < ntiles) { const int kn = (tn % nkt) * 64, scn = wcol_map((tn / nkt) * 64, mode);
            p0 = *(const f32x4*)(src + (size_t)(kn + r) * N + scn + c4); p1 = *(const f32x4*)(src + (size_t)(kn + r + 32) * N + scn + c4); }
        tile[r * 65 + c4 + 0] = v0[0]; tile[r * 65 + c4 + 1] = v0[1]; tile[r * 65 + c4 + 2] = v0[2]; tile[r * 65 + c4 + 3] = v0[3];
        tile[(r + 32) * 65 + c4 + 0] = v1[0]; tile[(r + 32) * 65 + c4 + 1] = v1[1]; tile[(r + 32) * 65 + c4 + 2] = v1[2]; tile[(r + 32) * 65 + c4 + 3] = v1[3];
        __syncthreads();
        { const int n = tid >> 3, k8 = (tid & 7) * 8; f32x4 a, b;
#pragma unroll
          for (int j = 0; j < 4; ++j) { a[j] = tile[(k8 + j) * 65 + n]; b[j] = tile[(k8 + 4 + j) * 65 + n]; }
          *(u32x4*)(dst + (size_t)(n0 + n) * K + k0 + k8) = pack8(a, b); }
        __syncthreads();
        v0 = p0; v1 = p1; t = tn;
    }
}
__device__ void mod_phase(LAS unsigned char* lds, const float* c, const float* ada_w, const float* ada_b, const float* hgrn_lb, float* mod, float* oml) {
    LAS float* cs = (LAS float*)lds;
    LAS float* red = (LAS float*)(lds + 32768);
    const int tid = threadIdx.x;
    constexpr int NT = (NMOD * DM) / 36;
    for (int i = tid; i < 8 * DM; i += 512) cs[i] = fsilu(c[i]);
    __syncthreads();
    for (int task = blockIdx.x; task < NT; task += gridDim.x) {
        const int j0 = task * 36;
        if (tid < 288) {
            const int q = tid % 9, kg = tid / 9;
            f32x4 acc[8];
#pragma unroll
            for (int b = 0; b < 8; ++b) acc[b] = (f32x4){0.f, 0.f, 0.f, 0.f};
            const float* wp = ada_w + (size_t)(kg * 32) * (NMOD * DM) + j0 + 4 * q;
#pragma unroll
            for (int k8 = 0; k8 < 32; k8 += 8) {
                f32x4 w[8];
#pragma unroll
                for (int i = 0; i < 8; ++i) w[i] = *(const f32x4*)(wp + (size_t)(k8 + i) * (NMOD * DM));
#pragma unroll
                for (int b = 0; b < 8; ++b) { const f32x4 c0 = *(const LAS f32x4*)(cs + b * DM + kg * 32 + k8), c1 = *(const LAS f32x4*)(cs + b * DM + kg * 32 + k8 + 4);
                    acc[b] += c0[0] * w[0] + c0[1] * w[1] + c0[2] * w[2] + c0[3] * w[3] + c1[0] * w[4] + c1[1] * w[5] + c1[2] * w[6] + c1[3] * w[7]; }
            }
#pragma unroll
            for (int b = 0; b < 8; ++b) { red[(kg * 8 + b) * 36 + 4 * q + 0] = acc[b][0]; red[(kg * 8 + b) * 36 + 4 * q + 1] = acc[b][1]; red[(kg * 8 + b) * 36 + 4 * q + 2] = acc[b][2]; red[(kg * 8 + b) * 36 + 4 * q + 3] = acc[b][3]; }
        }
        __syncthreads();
        if (tid < 288) { const int b = tid / 36, col = tid % 36; float sacc = ada_b[j0 + col];
#pragma unroll
            for (int g = 0; g < 32; ++g) sacc += red[(g * 8 + b) * 36 + col];
            mod[(size_t)b * (NMOD * DM) + j0 + col] = sacc; }
        __syncthreads();
    }
    if (blockIdx.x == gridDim.x - 1) {
        for (int d = tid; d < DM; d += 512) { const float a0 = hgrn_lb[d], a1 = hgrn_lb[DM + d]; const float lb = 1.0f / (1.0f + expf(a1 - a0)); oml[d] = 1.0f - lb; }
    }
}
__device__ void norm_mod_phase(const float* x, const float* gw, const float* mod, int shidx, bf16_t* h) {
    const int wid = threadIdx.x >> 6, lane = threadIdx.x & 63; const int nw = gridDim.x * 8;
    for (int base = (blockIdx.x * 8 + wid) * 16; base < MTOK; base += nw * 16) {
        const float* mp = mod + (size_t)(base >> 12) * (NMOD * DM) + shidx * DM;
        f32x4 wv[4], sv[4];
#pragma unroll
        for (int i = 0; i < 4; ++i) { const int c = i * 256 + lane * 4; wv[i] = *(const f32x4*)(gw + c) * (*(const f32x4*)(mp + DM + c) + 1.0f); sv[i] = *(const f32x4*)(mp + c); }
        for (int r0 = 0; r0 < 16; r0 += 2) {
            f32x4 v[2][4]; float ss[2];
#pragma unroll
            for (int u = 0; u < 2; ++u)
#pragma unroll
                for (int i = 0; i < 4; ++i) v[u][i] = *(const f32x4*)(x + (size_t)(base + r0 + u) * DM + i * 256 + lane * 4);
#pragma unroll
            for (int u = 0; u < 2; ++u) { float t = 0.f;
#pragma unroll
                for (int i = 0; i < 4; ++i) t += v[u][i][0] * v[u][i][0] + v[u][i][1] * v[u][i][1] + v[u][i][2] * v[u][i][2] + v[u][i][3] * v[u][i][3];
#pragma unroll
                for (int o = 32; o >= 1; o >>= 1) t += __shfl_xor(t, o);
                ss[u] = rsqrtf(t * (1.0f / DM) + EPS); }
#pragma unroll
            for (int u = 0; u < 2; ++u)
#pragma unroll
                for (int i = 0; i < 4; ++i) { const f32x4 y = v[u][i] * ss[u] * wv[i] + sv[i]; u32x2 w; w.x = cvt_pk_bf16(y[0], y[1]); w.y = cvt_pk_bf16(y[2], y[3]);
                    *(u32x2*)(h + (size_t)(base + r0 + u) * DM + i * 256 + lane * 4) = w; }
        }
    }
}
__device__ void norm_mod_phase_b(const bf16_t* x, const float* gw, const float* mod, int shidx, bf16_t* h) {
    const int wid = threadIdx.x >> 6, lane = threadIdx.x & 63; const int nw = gridDim.x * 8;
    for (int base = (blockIdx.x * 8 + wid) * 16; base < MTOK; base += nw * 16) {
        const float* mp = mod + (size_t)(base >> 12) * (NMOD * DM) + shidx * DM;
        f32x4 wv[4], sv[4];
#pragma unroll
        for (int i = 0; i < 4; ++i) { const int c = (i >> 1) * 512 + lane * 8 + (i & 1) * 4; wv[i] = *(const f32x4*)(gw + c) * (*(const f32x4*)(mp + DM + c) + 1.0f); sv[i] = *(const f32x4*)(mp + c); }
        for (int r0 = 0; r0 < 16; r0 += 2) {
            u32x4 raw[2][2]; f32x4 v[2][4]; float ss[2];
#pragma unroll
            for (int u = 0; u < 2; ++u) { const bf16_t* xr = x + (size_t)(base + r0 + u) * DM; raw[u][0] = *(const u32x4*)(xr + lane * 8); raw[u][1] = *(const u32x4*)(xr + 512 + lane * 8); }
#pragma unroll
            for (int u = 0; u < 2; ++u) { unpack8(raw[u][0], v[u][0], v[u][1]); unpack8(raw[u][1], v[u][2], v[u][3]); float t = 0.f;
#pragma unroll
                for (int i = 0; i < 4; ++i) t += v[u][i][0] * v[u][i][0] + v[u][i][1] * v[u][i][1] + v[u][i][2] * v[u][i][2] + v[u][i][3] * v[u][i][3];
#pragma unroll
                for (int o = 32; o >= 1; o >>= 1) t += __shfl_xor(t, o);
                ss[u] = rsqrtf(t * (1.0f / DM) + EPS); }
#pragma unroll
            for (int u = 0; u < 2; ++u) { f32x4 y[4];
#pragma unroll
                for (int i = 0; i < 4; ++i) y[i] = v[u][i] * ss[u] * wv[i] + sv[i];
                bf16_t* hr = h + (size_t)(base + r0 + u) * DM; *(u32x4*)(hr + lane * 8) = pack8(y[0], y[1]); *(u32x4*)(hr + 512 + lane * 8) = pack8(y[2], y[3]); }
        }
    }
}
__device__ void final_norm_phase_b(const bf16_t* x, const bf16_t* D, const float* gate, float scale, const float* gw, float* out) {
    const int wid = threadIdx.x >> 6, lane = threadIdx.x & 63; const int nw = gridDim.x * 8;
    f32x4 gv[4];
#pragma unroll
    for (int i = 0; i < 4; ++i) gv[i] = *(const f32x4*)(gw + (i >> 1) * 512 + lane * 8 + (i & 1) * 4);
    for (int base = (blockIdx.x * 8 + wid) * 16; base < MTOK; base += nw * 16) {
        const float* gp = gate + (size_t)(base >> 12) * (NMOD * DM);
        f32x4 gt[4];
#pragma unroll
        for (int i = 0; i < 4; ++i) gt[i] = *(const f32x4*)(gp + (i >> 1) * 512 + lane * 8 + (i & 1) * 4) * scale;
        for (int r0 = 0; r0 < 16; r0 += 2) {
            u32x4 raw[2][2], rd[2][2]; f32x4 v[2][4]; float ss[2];
#pragma unroll
            for (int u = 0; u < 2; ++u) { const size_t ro = (size_t)(base + r0 + u) * DM; raw[u][0] = *(const u32x4*)(x + ro + lane * 8); raw[u][1] = *(const u32x4*)(x + ro + 512 + lane * 8);
                rd[u][0] = *(const u32x4*)(D + ro + lane * 8); rd[u][1] = *(const u32x4*)(D + ro + 512 + lane * 8); }
#pragma unroll
            for (int u = 0; u < 2; ++u) { f32x4 dv[4]; unpack8(raw[u][0], v[u][0], v[u][1]); unpack8(raw[u][1], v[u][2], v[u][3]); unpack8(rd[u][0], dv[0], dv[1]); unpack8(rd[u][1], dv[2], dv[3]);
                float t = 0.f;
#pragma unroll
                for (int i = 0; i < 4; ++i) { v[u][i] += gt[i] * dv[i]; t += v[u][i][0] * v[u][i][0] + v[u][i][1] * v[u][i][1] + v[u][i][2] * v[u][i][2] + v[u][i][3] * v[u][i][3]; }
#pragma unroll
                for (int o = 32; o >= 1; o >>= 1) t += __shfl_xor(t, o);
                ss[u] = rsqrtf(t * (1.0f / DM) + EPS); }
#pragma unroll
            for (int u = 0; u < 2; ++u)
#pragma unroll
                for (int i = 0; i < 4; ++i) *(f32x4*)(out + (size_t)(base + r0 + u) * DM + (i >> 1) * 512 + lane * 8 + (i & 1) * 4) = v[u][i] * ss[u] * gv[i];
        }
    }
}
__device__ void final_norm_phase(float* x, const float* gw) {
    const int wid = threadIdx.x >> 6, lane = threadIdx.x & 63;
    for (int row = blockIdx.x * 8 + wid; row < MTOK; row += gridDim.x * 8) {
        float* xr = x + (size_t)row * DM; f32x4 v[4]; float ss = 0.f;
#pragma unroll
        for (int i = 0; i < 4; ++i) { v[i] = *(const f32x4*)(xr + i * 256 + lane * 4); ss += v[i][0] * v[i][0] + v[i][1] * v[i][1] + v[i][2] * v[i][2] + v[i][3] * v[i][3]; }
#pragma unroll
        for (int o = 32; o >= 1; o >>= 1) ss += __shfl_xor(ss, o);
        const float r = rsqrtf(ss * (1.0f / DM) + EPS);
#pragma unroll
        for (int i = 0; i < 4; ++i) { const int c = i * 256 + lane * 4; const f32x4 g = *(const f32x4*)(gw + c); *(f32x4*)(xr + c) = v[i] * r * g; }
    }
}
__device__ void conv_phase(LAS unsigned char* lds, const bf16_t* ug, const float* cw, const float* cb, const float* lng, const float* lnb, bf16_t* out, int first, int step) {
    constexpr int T = 32, ROWS = T + 30;
    LAS unsigned* tile = (LAS unsigned*)lds;
    LAS float* wred = (LAS float*)(lds + ROWS * 2048);
    LAS float* stat = (LAS float*)(lds + ROWS * 2048 + 1024);
    const int tid = threadIdx.x, wid = tid >> 6, lane = tid & 63, c0 = tid * 2;
    f32x2 w[31];
#pragma unroll
    for (int j = 0; j < 31; ++j) w[j] = *(const f32x2*)(cw + j * DM + c0);
    const f32x2 bias = *(const f32x2*)(cb + c0), lg = *(const f32x2*)(lng + c0), lb = *(const f32x2*)(lnb + c0);
    for (int blk = first; blk < MTOK / T; blk += step) {
        const int tok0 = blk * T, tseq = tok0 & (SEQ - 1);
#pragma unroll
        for (int k = 0; k < 16; ++k) { const int idx = tid + 512 * k;
            if (idx < ROWS * 128) { const int row = idx >> 7, pc = idx & 127; u32x4 v = (u32x4){0u, 0u, 0u, 0u};
                if (tseq - 30 + row >= 0) v = *(const u32x4*)(ug + (size_t)(tok0 - 30 + row) * DM + pc * 8);
                *(LAS u32x4*)(tile + row * 512 + pc * 4) = v; } }
        __syncthreads();
#pragma unroll 1
        for (int half = 0; half < 2; ++half) {
            const LAS unsigned* trow = tile + (16 * half) * 512 + tid;
            f32x2 acc[16];
#pragma unroll
            for (int t = 0; t < 16; ++t) acc[t] = bias;
#pragma unroll
            for (int i = 0; i < 46; ++i) {
                const unsigned raw = trow[i * 512];
                const f32x2 uv = (f32x2){bflo(raw), bfhi(raw)};
#pragma unroll
                for (int t = 0; t < 16; ++t) { const int j = i - t; if (j >= 0 && j <= 30) acc[t] += w[j] * uv; }
            }
            float v[32];
#pragma unroll
            for (int t = 0; t < 16; ++t) { v[t] = acc[t].x + acc[t].y; v[16 + t] = acc[t].x * acc[t].x + acc[t].y * acc[t].y; }
#pragma unroll
            for (int i = 0; i < 32; ++i) v[i] += __shfl_xor(v[i], 32);
#pragma unroll
            for (int i = 0; i < 16; ++i) { const bool up = (lane & 16) != 0; const float send = up ? v[i] : v[i + 16], keep = up ? v[i + 16] : v[i]; v[i] = keep + __shfl_xor(send, 16); }
#pragma unroll
            for (int i = 0; i < 8; ++i) { const bool up = (lane & 8) != 0; const float send = up ? v[i] : v[i + 8], keep = up ? v[i + 8] : v[i]; v[i] = keep + __shfl_xor(send, 8); }
#pragma unroll
            for (int i = 0; i < 4; ++i) { const bool up = (lane & 4) != 0; const float send = up ? v[i] : v[i + 4], keep = up ? v[i + 4] : v[i]; v[i] = keep + __shfl_xor(send, 4); }
#pragma unroll
            for (int i = 0; i < 2; ++i) { const bool up = (lane & 2) != 0; const float send = up ? v[i] : v[i + 2], keep = up ? v[i + 2] : v[i]; v[i] = keep + __shfl_xor(send, 2); }
            { const bool up = (lane & 1) != 0; const float send = up ? v[0] : v[1], keep = up ? v[1] : v[0]; v[0] = keep + __shfl_xor(send, 1); }
            if (lane < 32) wred[wid * 32 + lane] = v[0];
            __syncthreads();
            if (tid < 16) { float s1 = 0.f, s2 = 0.f;
#pragma unroll
                for (int g = 0; g < 8; ++g) { s1 += wred[g * 32 + tid]; s2 += wred[g * 32 + 16 + tid]; }
                const float mean = s1 * (1.0f / DM); const float var = fmaxf(s2 * (1.0f / DM) - mean * mean, 0.f);
                stat[tid] = mean; stat[16 + tid] = rsqrtf(var + EPS); }
            __syncthreads();
#pragma unroll
            for (int t = 0; t < 16; ++t) { const float mean = stat[t], rs = stat[16 + t];
                const float y0 = (acc[t].x - mean) * rs * lg.x + lb.x, y1 = (acc[t].y - mean) * rs * lg.y + lb.y;
                tile[(16 * half + t) * 512 + tid] = cvt_pk_bf16(fsilu(y0), fsilu(y1)); }
            __syncthreads();
        }
#pragma unroll
        for (int k = 0; k < 8; ++k) { const int idx = tid + 512 * k, row = idx >> 7, pc = idx & 127;
            *(u32x4*)(out + (size_t)(tok0 + row) * DM + pc * 8) = *(const LAS u32x4*)(tile + row * 512 + pc * 4); }
        __syncthreads();
    }
}

constexpr int QS_LD = 136, KT_LD = 72;
constexpr int H_QS = 0, H_KS = H_QS + 64 * QS_LD * 2, H_KT = H_KS + 64 * QS_LD * 2, H_VT = H_KT + 128 * KT_LD * 2, H_ST = H_VT + 128 * KT_LD * 2,
              H_AT = H_ST + 128 * QS_LD * 2, H_EL = H_AT + 64 * KT_LD * 2, H_SSQ = H_EL + 128 * 4, H_OS = H_SSQ + 64 * 2 * 4, H_END = H_OS + 64 * QS_LD * 2;
static_assert(H_END <= LDS_MAIN, "hgrn lds");
template <int N> __device__ __forceinline__ float row_shr_or_one(float x) {
    return __builtin_bit_cast(float, __builtin_amdgcn_update_dpp(0x3f800000, __builtin_bit_cast(int, x), 0x110 + N, 0xf, 0xf, false));
}
__device__ __forceinline__ void hgrn_unit(LAS unsigned char* lds, int bh, const bf16_t* qh, const bf16_t* kk, bf16_t* vo, const bf16_t* sog, const float* hg) {
    LAS bf16_t* Qs = (LAS bf16_t*)(lds + H_QS); LAS bf16_t* Ks = (LAS bf16_t*)(lds + H_KS); LAS bf16_t* KT = (LAS bf16_t*)(lds + H_KT);
    LAS bf16_t* VT = (LAS bf16_t*)(lds + H_VT); LAS bf16_t* ST = (LAS bf16_t*)(lds + H_ST); LAS bf16_t* AT = (LAS bf16_t*)(lds + H_AT);
    LAS float* elast = (LAS float*)(lds + H_EL); LAS float* ssq = (LAS float*)(lds + H_SSQ); LAS bf16_t* Os = (LAS bf16_t*)(lds + H_OS);
    const int tid = threadIdx.x, wid = tid >> 6, lane = tid & 63, fr = lane & 15, fq = lane >> 4;
    const int b = bh >> 3, h = bh & 7; const size_t tokb = (size_t)b * SEQ;
    const int ti = wid >> 1, vh = wid & 1;
    const bf16_t* qp = qh + (tokb + lane) * DM + h * 128 + 16 * wid;
    const bf16_t* kp = kk + (tokb + lane) * DM + h * 128 + 16 * wid;
    const int vs = tid >> 3, v16 = (tid & 7) * 16;
    bf16_t* vp = vo + (tokb + vs) * DM + h * 128 + v16;
    const bf16_t* sp = sog + (tokb + vs) * DM + h * 128 + v16;
    float gq[4];
#pragma unroll
    for (int jj = 0; jj < 4; ++jj) gq[jj] = hg[h * 128 + 64 * vh + 16 * jj + fr];
    for (int i = tid; i < 128 * QS_LD; i += 512) ST[i] = 0;
    f32x4 sacc[8];
#pragma unroll
    for (int vi = 0; vi < 8; ++vi) sacc[vi] = (f32x4){0.f, 0.f, 0.f, 0.f};
    u32x4 kr0 = *(const u32x4*)kp, kr1 = *(const u32x4*)(kp + 8), qr0 = *(const u32x4*)qp, qr1 = *(const u32x4*)(qp + 8);
    u32x4 vr0 = *(const u32x4*)vp, vr1 = *(const u32x4*)(vp + 8);
    __syncthreads();
    for (int c = 0; c < SEQ / 64; ++c) {
        const size_t cadv = (size_t)c * 64 * DM;
        const u32x4 sg0 = *(const u32x4*)(sp + cadv), sg1 = *(const u32x4*)(sp + cadv + 8);
        { f32x4 kf[4], qf[4]; unpack8(kr0, kf[0], kf[1]); unpack8(kr1, kf[2], kf[3]); unpack8(qr0, qf[0], qf[1]); unpack8(qr1, qf[2], qf[3]);
          const int row = lane >> 4;
          unsigned qw[8], kw[8]; f32x4 plast[4];
#pragma unroll
          for (int g4 = 0; g4 < 4; ++g4) {
              f32x4 e4, r4;
#pragma unroll
              for (int j = 0; j < 4; ++j) {
                  float x = 1.0f - kf[g4][j];
                  x *= row_shr_or_one<1>(x); x *= row_shr_or_one<2>(x); x *= row_shr_or_one<4>(x); x *= row_shr_or_one<8>(x);
                  const int xi = __builtin_bit_cast(int, x);
                  const float r0 = __builtin_bit_cast(float, __builtin_amdgcn_readlane(xi, 15)), r1 = __builtin_bit_cast(float, __builtin_amdgcn_readlane(xi, 31)),
                              r2 = __builtin_bit_cast(float, __builtin_amdgcn_readlane(xi, 47)), r3 = __builtin_bit_cast(float, __builtin_amdgcn_readlane(xi, 63));
                  const float m01 = r0 * r1, m012 = m01 * r2;
                  const float mult = row == 0 ? 1.0f : (row == 1 ? r0 : (row == 2 ? m01 : m012));
                  x *= mult;
                  e4[j] = x; r4[j] = __builtin_amdgcn_rcpf(x); plast[g4][j] = m012 * r3; }
              const f32x4 qs = qf[g4] * e4, ks = kf[g4] * r4;
              qw[2 * g4] = cvt_pk_bf16(qs[0], qs[1]); qw[2 * g4 + 1] = cvt_pk_bf16(qs[2], qs[3]);
              kw[2 * g4] = cvt_pk_bf16(ks[0], ks[1]); kw[2 * g4 + 1] = cvt_pk_bf16(ks[2], ks[3]); }
          *(LAS u32x4*)(Qs + lane * QS_LD + 16 * wid) = (u32x4){qw[0], qw[1], qw[2], qw[3]}; *(LAS u32x4*)(Qs + lane * QS_LD + 16 * wid + 8) = (u32x4){qw[4], qw[5], qw[6], qw[7]};
          *(LAS u32x4*)(Ks + lane * QS_LD + 16 * wid) = (u32x4){kw[0], kw[1], kw[2], kw[3]}; *(LAS u32x4*)(Ks + lane * QS_LD + 16 * wid + 8) = (u32x4){kw[4], kw[5], kw[6], kw[7]};
#pragma unroll
          for (int i = 0; i < 8; ++i) { KT[(16 * wid + 2 * i) * KT_LD + lane] = (bf16_t)(kw[i] & 0xffffu); KT[(16 * wid + 2 * i + 1) * KT_LD + lane] = (bf16_t)(kw[i] >> 16); }
          if (lane == 0) {
#pragma unroll
              for (int g4 = 0; g4 < 4; ++g4) *(LAS f32x4*)(elast + 16 * wid + 4 * g4) = plast[g4]; } }
        { VT[(v16 + 0) * KT_LD + vs] = (bf16_t)(vr0.x & 0xffffu); VT[(v16 + 1) * KT_LD + vs] = (bf16_t)(vr0.x >> 16);
          VT[(v16 + 2) * KT_LD + vs] = (bf16_t)(vr0.y & 0xffffu); VT[(v16 + 3) * KT_LD + vs] = (bf16_t)(vr0.y >> 16);
          VT[(v16 + 4) * KT_LD + vs] = (bf16_t)(vr0.z & 0xffffu); VT[(v16 + 5) * KT_LD + vs] = (bf16_t)(vr0.z >> 16);
          VT[(v16 + 6) * KT_LD + vs] = (bf16_t)(vr0.w & 0xffffu); VT[(v16 + 7) * KT_LD + vs] = (bf16_t)(vr0.w >> 16);
          VT[(v16 + 8) * KT_LD + vs] = (bf16_t)(vr1.x & 0xffffu); VT[(v16 + 9) * KT_LD + vs] = (bf16_t)(vr1.x >> 16);
          VT[(v16 + 10) * KT_LD + vs] = (bf16_t)(vr1.y & 0xffffu); VT[(v16 + 11) * KT_LD + vs] = (bf16_t)(vr1.y >> 16);
          VT[(v16 + 12) * KT_LD + vs] = (bf16_t)(vr1.z & 0xffffu); VT[(v16 + 13) * KT_LD + vs] = (bf16_t)(vr1.z >> 16);
          VT[(v16 + 14) * KT_LD + vs] = (bf16_t)(vr1.w & 0xffffu); VT[(v16 + 15) * KT_LD + vs] = (bf16_t)(vr1.w >> 16); }
        if (c + 1 < SEQ / 64) {
            const size_t adv = cadv + (size_t)64 * DM;
            kr0 = *(const u32x4*)(kp + adv); kr1 = *(const u32x4*)(kp + adv + 8); qr0 = *(const u32x4*)(qp + adv); qr1 = *(const u32x4*)(qp + adv + 8);
            vr0 = *(const u32x4*)(vp + adv); vr1 = *(const u32x4*)(vp + adv + 8);
        }
        __syncthreads();
#pragma unroll
        for (int jj = 0; jj < 2; ++jj) {
            const int sj = 2 * (wid & 1) + jj;
            f32x4 a4 = (f32x4){0.f, 0.f, 0.f, 0.f};
            if (sj <= ti) {
#pragma unroll
                for (int kd = 0; kd < 4; ++kd) {
                    const bf16x8 av = *(const LAS bf16x8*)(Qs + (16 * ti + fr) * QS_LD + 32 * kd + 8 * fq);
                    const bf16x8 bv = *(const LAS bf16x8*)(Ks + (16 * sj + fr) * QS_LD + 32 * kd + 8 * fq);
                    a4 = __builtin_amdgcn_mfma_f32_16x16x32_bf16(av, bv, a4, 0, 0, 0);
                }
            }
#pragma unroll
            for (int j = 0; j < 4; ++j) { const int t = 16 * ti + 4 * fq + j, s_ = 16 * sj + fr; AT[t * KT_LD + s_] = (s_ <= t) ? f2bf(a4[j]) : (bf16_t)0; }
        }
        __syncthreads();
        f32x4 o4[4];
        { bf16x8 af[2], qf[4];
#pragma unroll
          for (int ks = 0; ks < 2; ++ks) af[ks] = *(const LAS bf16x8*)(AT + (16 * ti + fr) * KT_LD + 32 * ks + 8 * fq);
#pragma unroll
          for (int kd = 0; kd < 4; ++kd) qf[kd] = *(const LAS bf16x8*)(Qs + (16 * ti + fr) * QS_LD + 32 * kd + 8 * fq);
#pragma unroll
          for (int jj = 0; jj < 4; ++jj) { const int vrow = 64 * vh + 16 * jj + fr; f32x4 t4 = (f32x4){0.f, 0.f, 0.f, 0.f};
#pragma unroll
              for (int ks = 0; ks < 2; ++ks) t4 = __builtin_amdgcn_mfma_f32_16x16x32_bf16(af[ks], *(const LAS bf16x8*)(VT + vrow * KT_LD + 32 * ks + 8 * fq), t4, 0, 0, 0);
#pragma unroll
              for (int kd = 0; kd < 4; ++kd) t4 = __builtin_amdgcn_mfma_f32_16x16x32_bf16(qf[kd], *(const LAS bf16x8*)(ST + vrow * QS_LD + 32 * kd + 8 * fq), t4, 0, 0, 0);
              o4[jj] = t4; } }
#pragma unroll
        for (int j = 0; j < 4; ++j) { float p = (o4[0][j] * o4[0][j] + o4[1][j] * o4[1][j]) + (o4[2][j] * o4[2][j] + o4[3][j] * o4[3][j]);
            p += __shfl_xor(p, 1); p += __shfl_xor(p, 2); p += __shfl_xor(p, 4); p += __shfl_xor(p, 8);
            if (fr == 0) ssq[(16 * ti + 4 * fq + j) * 2 + vh] = p; }
        { bf16x8 kf2[2];
#pragma unroll
          for (int ks = 0; ks < 2; ++ks) kf2[ks] = *(const LAS bf16x8*)(KT + (16 * wid + fr) * KT_LD + 32 * ks + 8 * fq);
          const f32x4 el = *(const LAS f32x4*)(elast + 16 * wid + 4 * fq);
#pragma unroll
          for (int vi = 0; vi < 8; ++vi) {
#pragma unroll
              for (int ks = 0; ks < 2; ++ks) sacc[vi] = __builtin_amdgcn_mfma_f32_16x16x32_bf16(kf2[ks], *(const LAS bf16x8*)(VT + (16 * vi + fr) * KT_LD + 32 * ks + 8 * fq), sacc[vi], 0, 0, 0);
              sacc[vi] = sacc[vi] * el; } }
        __syncthreads();
#pragma unroll
        for (int j = 0; j < 4; ++j) { const int t = 16 * ti + 4 * fq + j; const float r = rsqrtf((ssq[t * 2] + ssq[t * 2 + 1]) * (1.0f / 128.0f) + EPS);
#pragma unroll
            for (int jj = 0; jj < 4; ++jj) Os[t * QS_LD + 64 * vh + 16 * jj + fr] = f2bf(o4[jj][j] * r * gq[jj]); }
#pragma unroll
        for (int vi = 0; vi < 8; ++vi) { u32x2 w; w.x = cvt_pk_bf16(sacc[vi][0], sacc[vi][1]); w.y = cvt_pk_bf16(sacc[vi][2], sacc[vi][3]);
            *(LAS u32x2*)(ST + (16 * vi + fr) * QS_LD + 16 * wid + 4 * fq) = w; }
        __syncthreads();
        { f32x4 ov[4], gv[4]; const u32x4 ow0 = *(const LAS u32x4*)(Os + vs * QS_LD + v16), ow1 = *(const LAS u32x4*)(Os + vs * QS_LD + v16 + 8); unpack8(ow0, ov[0], ov[1]); unpack8(ow1, ov[2], ov[3]);
          unpack8(sg0, gv[0], gv[1]); unpack8(sg1, gv[2], gv[3]);
          *(u32x4*)(vp + cadv) = pack8(ov[0] * gv[0], ov[1] * gv[1]); *(u32x4*)(vp + cadv + 8) = pack8(ov[2] * gv[2], ov[3] * gv[3]); }
    }
    __syncthreads();
}

#define XB_TMO      128
#define XB_XCNT(j)  (256  + 64 * (j))
#define XB_XSUB(j)  (1280 + 64 * (j))
#define XB_XGEN(j)  (2304 + 64 * (j))
#define XB_TOP      3328
#define XB_TOPGEN   3392
#define XCD_BAR_WORDS 3456
#define XB_SPIN_CAP (1u << 18)
__device__ __forceinline__ unsigned xb_ld(unsigned* p)              { return __hip_atomic_load(p, __ATOMIC_RELAXED, __HIP_MEMORY_SCOPE_AGENT); }
__device__ __forceinline__ unsigned xb_add(unsigned* p, unsigned v) { return __hip_atomic_fetch_add(p, v, __ATOMIC_RELAXED, __HIP_MEMORY_SCOPE_AGENT); }
__device__ __forceinline__ unsigned xb_xcc_id() { return (unsigned)__builtin_amdgcn_s_getreg((3 << 11) | 20) & 0xFu; }
#define XB_SPIN(cond, bar) do { unsigned _sp = 0; while (cond) { __builtin_amdgcn_s_sleep(1); \
    if ((++_sp & 255u) == 0u) { if (xb_ld(&(bar)[XB_TMO])) break; if (_sp > XB_SPIN_CAP) { atomicAdd(&(bar)[XB_TMO], 1u); break; } } } } while (0)
struct XcdBarrier { unsigned* bar; unsigned x; volatile LAS unsigned* st; };
__device__ __forceinline__ XcdBarrier xcd_barrier_post(unsigned* bar, volatile LAS unsigned* st) {
    XcdBarrier b; b.bar = bar; b.x = xb_xcc_id(); b.st = st;
    if (threadIdx.x == 0) (void)xb_add(&bar[XB_XCNT(b.x)], 1u);
    return b;
}
__device__ __forceinline__ void xcd_barrier_complete(unsigned* bar, unsigned x, unsigned& nloc, unsigned& nx) {
    const unsigned G = gridDim.x * gridDim.y * gridDim.z;
    unsigned sum, cnt, mine, sp = 0u;
    for (;;) {
        sum = 0u; cnt = 0u; mine = 0u;
#pragma unroll
        for (unsigned j = 0; j < 16; ++j) { const unsigned c = xb_ld(&bar[XB_XCNT(j)]); sum += c; cnt += (c > 0u) ? 1u : 0u; mine = (j == x) ? c : mine; }
        if (sum == G) break;
        __builtin_amdgcn_s_sleep(1);
        if ((++sp & 255u) == 0u) { if (xb_ld(&bar[XB_TMO])) break; if (sp > XB_SPIN_CAP) { atomicAdd(&bar[XB_TMO], 1u); break; } }
    }
    nloc = mine > 0u ? mine : 1u; nx = cnt > 0u ? cnt : 1u;
}
__device__ __forceinline__ void xcd_barrier(const XcdBarrier& b) {
    asm volatile("s_waitcnt vmcnt(0)" ::: "memory");
    __syncthreads();
    if (threadIdx.x == 0) {
        unsigned* bar = b.bar;
        __builtin_amdgcn_s_waitcnt(0);
        unsigned nloc = b.st[0], nx = b.st[1];
        if (nloc == 0u) { xcd_barrier_complete(bar, b.x, nloc, nx); b.st[0] = nloc; b.st[1] = nx; }
        const unsigned old = xb_add(&bar[XB_XSUB(b.x)], 1u);
        const unsigned gen = old / nloc;
        if (old + 1u == (gen + 1u) * nloc) {
            __builtin_amdgcn_fence(__ATOMIC_RELEASE, "agent");
            asm volatile("s_waitcnt vmcnt(0)" ::: "memory");
            const unsigned og = xb_add(&bar[XB_TOP], 1u);
            const unsigned tg = og / nx;
            if (og + 1u == (tg + 1u) * nx) xb_add(&bar[XB_TOPGEN], 1u);
            else XB_SPIN(xb_ld(&bar[XB_TOPGEN]) == tg, bar);
            __builtin_amdgcn_fence(__ATOMIC_ACQUIRE, "agent");
            xb_add(&bar[XB_XGEN(b.x)], 1u);
            asm volatile("s_waitcnt vmcnt(0)" ::: "memory");
        } else {
            XB_SPIN(xb_ld(&bar[XB_XGEN(b.x)]) == gen, bar);
            __builtin_amdgcn_fence(__ATOMIC_ACQUIRE, "agent");
            asm volatile("s_waitcnt vmcnt(0)" ::: "memory");
        }
    }
    __syncthreads();
}

__device__ __forceinline__ void group_barrier(unsigned* word, unsigned n) {
    asm volatile("s_waitcnt vmcnt(0)" ::: "memory");
    __syncthreads();
    if (threadIdx.x == 0) {
        __builtin_amdgcn_fence(__ATOMIC_RELEASE, "agent");
        asm volatile("s_waitcnt vmcnt(0)" ::: "memory");
        (void)xb_add(word, 1u);
        unsigned sp = 0u; while (xb_ld(word) < n) { __builtin_amdgcn_s_sleep(1); if (++sp > (1u << 22)) break; }
        __builtin_amdgcn_fence(__ATOMIC_ACQUIRE, "agent");
        asm volatile("s_waitcnt vmcnt(0)" ::: "memory");
    }
    __syncthreads();
}

__global__ __launch_bounds__(512, 2) void fwd_kernel(Args a) {
    extern __shared__ __attribute__((aligned(16))) unsigned char shm[];
    LAS unsigned char* lds = (LAS unsigned char*)shm;
    cg::grid_group grid = cg::this_grid();
    unsigned char* ws = a.ws;
    bf16_t* W1in = (bf16_t*)(ws + OFF_W1IN); bf16_t* W1out = (bf16_t*)(ws + OFF_W1OUT); bf16_t* Wmix = (bf16_t*)(ws + OFF_WMIX);
    bf16_t* Who = (bf16_t*)(ws + OFF_WHO); bf16_t* Wco = (bf16_t*)(ws + OFF_WCO); bf16_t* Wmo = (bf16_t*)(ws + OFF_WMO);
    bf16_t* W2in = (bf16_t*)(ws + OFF_W2IN); bf16_t* W2out = (bf16_t*)(ws + OFF_W2OUT);
    float* mod = (float*)(ws + OFF_MOD); float* oml = (float*)(ws + OFF_LB);
    bf16_t* hbuf = (bf16_t*)(ws + OFF_HBUF); bf16_t* act = (bf16_t*)(ws + OFF_R); bf16_t* P = (bf16_t*)(ws + OFF_R);
    bf16_t* slot0 = P, *slot1 = P + SLOT / 2, *slot2 = P + 2 * (SLOT / 2), *slot3 = P + 3 * (SLOT / 2), *slot4 = P + 4 * (SLOT / 2);
    const float* x = a.in[0]; float* xres = a.out; bf16_t* xs = (bf16_t*)(ws + OFF_XRES);
    bf16_t* dsl0 = (bf16_t*)a.out; bf16_t* dsl1 = dsl0 + SLOT / 2;
    LAS unsigned* xbst = (LAS unsigned*)(lds + LDS_MAIN);
    XcdBarrier xb; xb.bar = (unsigned*)(ws + OFF_BAR); xb.x = 0; xb.st = (volatile LAS unsigned*)xbst;
    if (a.coop) {
        if (threadIdx.x == 0) { xbst[0] = 0u; xbst[1] = 0u; xbst[2] = 0u; xbst[3] = 0u; }
        __syncthreads();
        if (blockIdx.x == 0) { unsigned* bw = (unsigned*)(ws + OFF_BAR);
            for (int i = threadIdx.x; i < XCD_BAR_WORDS; i += 512) __hip_atomic_store(bw + i, 0u, __ATOMIC_RELAXED, __HIP_MEMORY_SCOPE_AGENT);
            __threadfence(); }
        grid.sync();
        xb = xcd_barrier_post((unsigned*)(ws + OFF_BAR), (volatile LAS unsigned*)xbst);
    }
#define PHASE(p) if (a.ph_lo <= (p) && (p) < a.ph_hi)
#define SYNC(p) do { if (a.coop && a.ph_lo <= (p) && (p) + 1 < a.ph_hi) { xcd_barrier(xb); } } while (0)
    PHASE(0) for (int rep = 0; rep < (DUP_PHASE == 0 ? 2 : 1); ++rep) {
        mod_phase(lds, a.in[1], a.in[2], a.in[3], a.in[9], mod, oml);
        conv_weight(lds, a.in[5], W1in, DM, 2 * DFF, 1);
        conv_weight(lds, a.in[6], W1out, DFF, DM, 0);
        conv_weight(lds, a.in[8], Wmix, DM, 8192, 2);
        conv_weight(lds, a.in[11], Who, DM, DM, 0);
        conv_weight(lds, a.in[16], Wco, DM, DM, 0);
        conv_weight(lds, a.in[17], Wmo, DM, DM, 0);
        conv_weight(lds, a.in[19], W2in, DM, 2 * DFF, 1);
        conv_weight(lds, a.in[20], W2out, DFF, DM, 0);
    }
    SYNC(0);
    PHASE(1) for (int rep = 0; rep < (DUP_PHASE == 1 ? 2 : 1); ++rep) norm_mod_phase(x, a.in[4], mod, 0, hbuf);
    SYNC(1);
    PHASE(2) for (int rep = 0; rep < (DUP_PHASE == 2 ? 2 : 1); ++rep) { pg8::Gemm g{hbuf, W1in, MTOK, 2 * DFF, DM}; EpiSwiGLU E{act, DFF}; pg8::gemm_phase(lds, g, E); }
    SYNC(2);
    PHASE(3) for (int rep = 0; rep < (DUP_PHASE == 3 ? 2 : 1); ++rep) { pg8::Gemm g{act, W1out, MTOK, DM, DFF}; EpiResidB<1, 1> E{x, xs, mod + 2 * DM}; pg8::gemm_phase(lds, g, E); }
    SYNC(3);
    PHASE(4) norm_mod_phase_b(xs, a.in[7], mod, 3, hbuf);
    SYNC(4);
    PHASE(5) { pg8::Gemm g{hbuf, Wmix, MTOK, 4096, DM}; EpiMixA E{P, oml}; pg8::gemm_phase(lds, g, E); }
    SYNC(5);
    const bool split = (gridDim.x == 256) && a.coop;
    const int sl_ = blockIdx.x >> 3, xc_ = blockIdx.x & 7; const bool scan_wg = split && ((sl_ & 3) == 0);
    const int pidx = (sl_ - (sl_ >> 2) - 1) * 8 + xc_;
    PHASE(6) {
        pg8::Gemm g{hbuf, Wmix + (size_t)4096 * DM, MTOK, 4096, DM}; EpiMixB E{slot4, dsl0, dsl1};
        const int hfirst = split ? (scan_wg ? (sl_ >> 2) * 8 + xc_ : 64) : (int)blockIdx.x, hstep = split ? 64 : (int)gridDim.x;
        for (int bh = hfirst; bh < 64; bh += hstep) hgrn_unit(lds, bh, slot0, slot1, slot2, slot3, a.in[10]);
        if (!scan_wg) {
            const pg8::Split sp = split ? pg8::Split{192, pidx, 0, 11} : pg8::Split{(int)gridDim.x, (int)blockIdx.x, 0, 1 << 30};
            pg8::gemm_phase(lds, g, E, sp);
            if (split) group_barrier((unsigned*)(ws + OFF_BAR) + 64, 192u);
        }
    }
    if (!split) SYNC(6);
    PHASE(7) conv_phase(lds, slot4, a.in[12], a.in[13], a.in[14], a.in[15], hbuf, split ? (scan_wg ? MTOK : pidx) : (int)blockIdx.x, split ? 192 : (int)gridDim.x);
    if (!split) SYNC(7);
    PHASE(8) {
        if (split && !scan_wg) group_barrier((unsigned*)(ws + OFF_BAR) + 96, 192u);
        if (!scan_wg) { pg8::Gemm g{hbuf, Wco, MTOK, DM, DM}; EpiGate<0> E{dsl1, nullptr};
            const pg8::Split sp = split ? pg8::Split{192, pidx, 0, 3} : pg8::Split{(int)gridDim.x, (int)blockIdx.x, 0, 1 << 30};
            pg8::gemm_phase(lds, g, E, sp); }
    }
    SYNC(8);
    PHASE(9) { pg8::Gemm g{slot2, Who, MTOK, DM, DM}; EpiGate<1> E{dsl0, dsl1}; pg8::gemm_phase(lds, g, E); }
    SYNC(9);
    PHASE(10) { pg8::Gemm g{dsl0, Wmo, MTOK, DM, DM}; EpiResidB<0, 0> E{x, xs, mod + 5 * DM}; pg8::gemm_phase(lds, g, E); }
    SYNC(10);
    PHASE(11) norm_mod_phase_b(xs, a.in[18], mod, 6, hbuf);
    SYNC(11);
    PHASE(12) { pg8::Gemm g{hbuf, W2in, MTOK, 2 * DFF, DM}; EpiSwiGLU E{act, DFF}; pg8::gemm_phase(lds, g, E); }
    SYNC(12);
    PHASE(13) { pg8::Gemm g{act, W2out, MTOK, DM, DFF}; EpiStore E{hbuf}; pg8::gemm_phase(lds, g, E); }
    SYNC(13);
    PHASE(14) final_norm_phase_b(xs, hbuf, mod + 8 * DM, 0.5f, a.in[21], xres);
#if DBG_DUMP >= 0
    PHASE(15) { const bf16_t* src = DBG_DUMP == 5 ? hbuf : P + (size_t)DBG_DUMP * (SLOT / 2);
        for (size_t i = (size_t)blockIdx.x * 512 + threadIdx.x; i < (size_t)MTOK * DM; i += (size_t)gridDim.x * 512) { const float v = bf2f(src[i]); xres[i] = (v - v == 0.f) ? v : 10000.f; } }
#endif
#undef PHASE
#undef SYNC
}
constexpr int NPHASE = 15;

extern "C" void kernel_launch(void* const* d_in, const int* in_sizes, int n_in, void* d_out, int out_size, void* d_ws, size_t ws_size, hipStream_t stream) {
    static int grid = 0;
    if (grid == 0) {
        if (n_in != 22 || out_size != MTOK * DM || ws_size < WS_NEED) { fprintf(stderr, "kernel_launch: unexpected shapes: n_in %d out %d ws %zu (need %zu)\n", n_in, out_size, ws_size, (size_t)WS_NEED); grid = -1; return; }
        int dev = 0, cus = 0, per_cu = 0;
        hipGetDevice(&dev);
        hipDeviceGetAttribute(&cus, hipDeviceAttributeMultiprocessorCount, dev);
        if (hipFuncSetAttribute((const void*)fwd_kernel, hipFuncAttributeMaxDynamicSharedMemorySize, LDS_BYTES) != hipSuccess) { fprintf(stderr, "kernel_launch: hipFuncSetAttribute failed\n"); grid = -1; return; }
        if (hipOccupancyMaxActiveBlocksPerMultiprocessor(&per_cu, (const void*)fwd_kernel, 512, LDS_BYTES) != hipSuccess || per_cu < 1) { fprintf(stderr, "kernel_launch: occupancy query says %d\n", per_cu); per_cu = 1; }
        (void)hipGetLastError();
        grid = cus * 1;
        if (grid > 256) grid = 256;
        fprintf(stderr, "kernel_launch: grid %d (cus %d, per_cu %d)\n", grid, cus, per_cu);
    }
    if (grid < 0) return;
    Args a{};
    for (int i = 0; i < 22; ++i) a.in[i] = (const float*)d_in[i];
    a.out = (float*)d_out; a.ws = (unsigned char*)d_ws;
#if ONE_LAUNCH
    a.ph_lo = 0; a.ph_hi = NPHASE; a.coop = 1;
    void* args[] = {&a};
    hipError_t e = hipLaunchCooperativeKernel((const void*)fwd_kernel, dim3(grid), dim3(512), args, LDS_BYTES, stream);
    if (e != hipSuccess) fprintf(stderr, "cooperative launch failed: %s (grid %d)\n", hipGetErrorString(e), grid);
#else
    for (int p = 0; p < 16; ++p) {
        if (p >= DBG_STOP && p != 15) continue;
        if (p == 15 && DBG_DUMP < 0) continue;
        a.ph_lo = p; a.ph_hi = p + 1; a.coop = 0;
        hipLaunchKernelGGL(fwd_kernel, dim3(grid), dim3(512), LDS_BYTES, stream, a);
    }
#endif
}
```

```cpp
#include <hip/hip_runtime.h>
#include <hip/hip_cooperative_groups.h>
#include <cstdio>
namespace cg = cooperative_groups;

#ifndef ONE_LAUNCH
#define ONE_LAUNCH 1
#endif
#ifndef DUP_PHASE
#define DUP_PHASE -1
#endif
#ifndef DBG_STOP
#define DBG_STOP 15
#endif
#ifndef DBG_DUMP
#define DBG_DUMP -1
#endif

#define LAS __attribute__((address_space(3)))
typedef unsigned short bf16_t;
typedef short bf16x8 __attribute__((ext_vector_type(8)));
typedef float f32x4 __attribute__((ext_vector_type(4)));
typedef float f32x2 __attribute__((ext_vector_type(2)));
typedef unsigned u32x4 __attribute__((ext_vector_type(4)));
typedef unsigned u32x2 __attribute__((ext_vector_type(2)));

constexpr int MTOK = 32768, DM = 1024, SEQ = 4096, DFF = 2816, NMOD = 9;
constexpr float EPS = 1e-6f;
constexpr int LDS_MAIN = 135168;
constexpr int LDS_BYTES = LDS_MAIN + 16;

constexpr size_t MiB = 1ull << 20;
constexpr size_t OFF_W1IN = 0;
constexpr size_t OFF_W1OUT = OFF_W1IN + 5632ull * 1024 * 2;
constexpr size_t OFF_WMIX = OFF_W1OUT + 1024ull * 2816 * 2;
constexpr size_t OFF_WHO = OFF_WMIX + 8192ull * 1024 * 2;
constexpr size_t OFF_WCO = OFF_WHO + 2 * MiB;
constexpr size_t OFF_WMO = OFF_WCO + 2 * MiB;
constexpr size_t OFF_W2IN = OFF_WMO + 2 * MiB;
constexpr size_t OFF_W2OUT = OFF_W2IN + 5632ull * 1024 * 2;
constexpr size_t OFF_MOD = 55 * MiB;
constexpr size_t OFF_LB = OFF_MOD + 512 * 1024;
constexpr size_t OFF_BAR = OFF_MOD + 768 * 1024;
constexpr size_t OFF_HBUF = 56 * MiB;
constexpr size_t OFF_R = 120 * MiB;
constexpr size_t SLOT = 64 * MiB;
constexpr size_t OFF_XRES = OFF_R + 5 * SLOT;
constexpr size_t WS_NEED = OFF_XRES + 64 * MiB;
static_assert(OFF_W2OUT + 1024ull * 2816 * 2 <= OFF_MOD, "weights overflow");

struct Args {
    const float* in[22];
    float* out;
    unsigned char* ws;
    int ph_lo, ph_hi;
    int coop, pad;
};

typedef __bf16 bf16x2_t __attribute__((ext_vector_type(2)));
__device__ __forceinline__ unsigned cvt_pk_bf16(float lo, float hi) { const f32x2 v = {lo, hi}; return __builtin_bit_cast(unsigned, __builtin_convertvector(v, bf16x2_t)); }
__device__ __forceinline__ bf16_t f2bf(float f) { return (bf16_t)(cvt_pk_bf16(f, 0.f) & 0xffffu); }
__device__ __forceinline__ float bf2f(bf16_t b) { return __uint_as_float(((unsigned)b) << 16); }
__device__ __forceinline__ float bflo(unsigned w) { return __uint_as_float(w << 16); }
__device__ __forceinline__ float bfhi(unsigned w) { return __uint_as_float(w & 0xffff0000u); }
__device__ __forceinline__ float fsigmoid(float x) { return __builtin_amdgcn_rcpf(1.0f + __expf(-x)); }
__device__ __forceinline__ float fsilu(float x) { return x * fsigmoid(x); }
__device__ __forceinline__ u32x4 pack8(const f32x4& a, const f32x4& b) {
    u32x4 w; w.x = cvt_pk_bf16(a[0], a[1]); w.y = cvt_pk_bf16(a[2], a[3]); w.z = cvt_pk_bf16(b[0], b[1]); w.w = cvt_pk_bf16(b[2], b[3]); return w;
}
__device__ __forceinline__ void unpack8(const u32x4& w, f32x4& a, f32x4& b) {
    a[0] = bflo(w.x); a[1] = bfhi(w.x); a[2] = bflo(w.y); a[3] = bfhi(w.y);
    b[0] = bflo(w.z); b[1] = bfhi(w.z); b[2] = bflo(w.w); b[3] = bfhi(w.w);
}

namespace pg8 {
constexpr int BM = 256, BK = 64, HALF = 128, HTB = HALF * BK * 2, STAGE_BYTES = 8 * HTB, NXCD = 8, WGM = 4;
__device__ __forceinline__ int lds_byte(int r, int c) { const int st = (r >> 4) * 2 + (c >> 5), rr = r & 15, cc = c & 31, ob = rr * 64 + cc * 2; return st * 1024 + (ob ^ (((ob >> 9) & 1) << 5)); }
__device__ __forceinline__ void stage_rc(int b, int& R, int& C) { const int st = b / 1024, sb = b % 1024, swz = sb ^ (((sb >> 9) & 1) << 5); R = (st >> 1) * 16 + swz / 64; C = (st & 1) * 32 + (swz % 64) / 2; }
__device__ __forceinline__ int perm32(int rho) { const int n = rho >> 4, i = rho & 15; return 8 * (i >> 2) + 4 * n + (i & 3); }
struct Unit { int pm, pn; };
struct Gemm { const bf16_t* A; const bf16_t* Bt; int M, N, K; };
struct StaticOrder {
    int nM, nN, nwg, G, c, base, cnt;
    __device__ void init(int M, int N, int G_, int c_, int base_, int cnt_) { nM = M / BM; nN = N / BM; nwg = nM * nN; G = G_; c = c_; base = base_; cnt = cnt_; }
    __device__ bool next(int i, Unit& u) const {
        if (i >= cnt) return false;
        const long L = (long)base + (long)i * G + c; if (L >= nwg) return false;
        int wgid = (int)L; { const int q = nwg / NXCD, r = nwg % NXCD, xcd = wgid % NXCD, off = wgid / NXCD; wgid = (xcd < r ? xcd * (q + 1) : r * (q + 1) + (xcd - r) * q) + off; }
        const int nig = WGM * nN, gid = wgid / nig, fm = gid * WGM, gsz = (nM - fm) < WGM ? (nM - fm) : WGM;
        u.pm = fm + ((wgid % nig) % gsz); u.pn = (wgid % nig) / gsz; return true;
    }
};

struct Split { int G, c, base, cnt; };
template <class Epi>
__device__ __forceinline__ void gemm_phase(LAS unsigned char* lds, const Gemm g, const Epi E, const Split sp) {
    const int tid = threadIdx.x, wid = __builtin_amdgcn_readfirstlane(tid >> 6), lane = tid & 63, wr = wid >> 2, wc = wid & 3, fr = lane & 15, fq = lane >> 4;
    const int K = g.K, nt = K / BK;
    StaticOrder S; S.init(g.M, g.N, sp.G, sp.c, sp.base, sp.cnt);
    unsigned voffA[2], voffB[2];
#pragma unroll
    for (int i = 0; i < 2; ++i) { int R, C; stage_rc(tid * 16 + i * 8192, R, C); const int Rb = Epi::PERM ? ((R & ~31) + perm32(R & 31)) : R;
        voffA[i] = (unsigned)(R * K + C) * 2u; voffB[i] = (unsigned)(Rb * K + C) * 2u; }
    const size_t kstep = (size_t)(BK * 2);
    const size_t hstep = (size_t)HALF * K * 2;
    const size_t tstep = 2 * hstep;
    const unsigned ldsw = (unsigned)wid * 1024u;
    const int aoff = lds_byte(wr * 64 + fr, fq * 8), boff = lds_byte(wc * 32 + fr, fq * 8);
#define PG8_SA(b, h) (((b) * 2 + (h)) * HTB)
#define PG8_SB(b, h) ((4 + (b) * 2 + (h)) * HTB)
#define PG8_STAGE(bufoff, gbase, voff) do { _Pragma("unroll") for (int _i = 0; _i < 2; ++_i) \
        __builtin_amdgcn_global_load_lds((const unsigned*)((const char*)(gbase) + (voff)[_i]), (LAS unsigned*)(lds + (bufoff) + ldsw + _i * 8192), 16, 0, 0); } while (0)
#define PG8_LDA(dst, b, h) do { _Pragma("unroll") for (int m = 0; m < 4; ++m) _Pragma("unroll") for (int k = 0; k < 2; ++k) dst[m][k] = *(const LAS bf16x8*)(lds + PG8_SA(b, h) + aoff + m * 2048 + k * 1024); } while (0)
#define PG8_LDB(dst, b, h) do { _Pragma("unroll") for (int n = 0; n < 2; ++n) _Pragma("unroll") for (int k = 0; k < 2; ++k) dst[n][k] = *(const LAS bf16x8*)(lds + PG8_SB(b, h) + boff + n * 2048 + k * 1024); } while (0)
#define PG8_MMA(ai, bj, At, Bt) do { __builtin_amdgcn_s_setprio(1); _Pragma("unroll") for (int m = 0; m < 4; ++m) _Pragma("unroll") for (int n = 0; n < 2; ++n) _Pragma("unroll") for (int k = 0; k < 2; ++k) \
        acc[ai][bj][m][n] = __builtin_amdgcn_mfma_f32_16x16x32_bf16(Bt[n][k], At[m][k], acc[ai][bj][m][n], 0, 0, 0); __builtin_amdgcn_s_setprio(0); } while (0)
#define PG8_WAIT_V(n) asm volatile("s_waitcnt vmcnt(" #n ")" ::: "memory")
#define PG8_WAIT_L(n) asm volatile("s_waitcnt lgkmcnt(" #n ")" ::: "memory")
#define PG8_BAR __builtin_amdgcn_s_barrier()
#define PG8_SCHED __builtin_amdgcn_sched_barrier(0)
    Unit cur, nxt; int ui = 0;
    if (!S.next(0, cur)) return;
    f32x4 acc[2][2][4][2];
#pragma unroll
    for (int a = 0; a < 2; ++a)
#pragma unroll
        for (int b = 0; b < 2; ++b)
#pragma unroll
            for (int m = 0; m < 4; ++m)
#pragma unroll
                for (int n = 0; n < 2; ++n) acc[a][b][m][n] = (f32x4){0.f, 0.f, 0.f, 0.f};
    bf16x8 At[4][2], B0[2][2], B1[2][2];
    const char* cA = (const char*)g.A + (size_t)cur.pm * tstep; const char* cB = (const char*)g.Bt + (size_t)cur.pn * tstep;
    PG8_STAGE(PG8_SB(0, 0), cB, voffB); PG8_STAGE(PG8_SA(0, 0), cA, voffA); PG8_STAGE(PG8_SB(0, 1), cB + hstep, voffB); PG8_STAGE(PG8_SA(0, 1), cA + hstep, voffA);
    if (wr == 1) PG8_BAR;
    PG8_WAIT_V(4); PG8_BAR;
    PG8_STAGE(PG8_SB(1, 0), cB + kstep, voffB); PG8_STAGE(PG8_SA(1, 0), cA + kstep, voffA); PG8_STAGE(PG8_SB(1, 1), cB + hstep + kstep, voffB);
    PG8_WAIT_V(6); PG8_BAR;
    for (;;) {
        const bool has_next = S.next(ui + 1, nxt);
        const char* nA = has_next ? (const char*)g.A + (size_t)nxt.pm * tstep : cA; const char* nB = has_next ? (const char*)g.Bt + (size_t)nxt.pn * tstep : cB;
        for (int t = 0; t < nt; t += 2) {
            const bool last = (t == nt - 2);
            const char* a1 = cA + (size_t)(t + 1) * kstep;
            const char* a2 = last ? nA : cA + (size_t)(t + 2) * kstep; const char* b2 = last ? nB : cB + (size_t)(t + 2) * kstep;
            const char* a3 = a2 + kstep; const char* b3 = b2 + kstep;
            PG8_LDB(B0, 0, 0); PG8_SCHED; PG8_LDA(At, 0, 0); PG8_STAGE(PG8_SA(1, 1), a1 + hstep, voffA);
            PG8_WAIT_L(8); PG8_BAR; PG8_WAIT_L(0); PG8_MMA(0, 0, At, B0); PG8_BAR; PG8_SCHED;
            PG8_LDB(B1, 0, 1); PG8_STAGE(PG8_SB(0, 0), b2, voffB);
            PG8_BAR; PG8_WAIT_L(0); PG8_MMA(0, 1, At, B1); PG8_BAR;
            PG8_LDA(At, 0, 1); PG8_STAGE(PG8_SA(0, 0), a2, voffA);
            PG8_BAR; PG8_WAIT_L(0); PG8_MMA(1, 0, At, B0); PG8_BAR; PG8_SCHED;
            PG8_STAGE(PG8_SB(0, 1), b2 + hstep, voffB);
            PG8_WAIT_V(6); PG8_BAR; PG8_MMA(1, 1, At, B1); PG8_BAR;
            PG8_LDB(B0, 1, 0); PG8_SCHED; PG8_LDA(At, 1, 0); PG8_STAGE(PG8_SA(0, 1), a2 + hstep, voffA);
            PG8_WAIT_L(8); PG8_BAR; PG8_WAIT_L(0); PG8_MMA(0, 0, At, B0); PG8_BAR; PG8_SCHED;
            PG8_LDB(B1, 1, 1); PG8_STAGE(PG8_SB(1, 0), b3, voffB);
            PG8_BAR; PG8_WAIT_L(0); PG8_MMA(0, 1, At, B1); PG8_BAR;
            PG8_LDA(At, 1, 1); PG8_STAGE(PG8_SA(1, 0), a3, voffA);
            PG8_BAR; PG8_WAIT_L(0); PG8_MMA(1, 0, At, B0); PG8_BAR; PG8_SCHED;
            PG8_STAGE(PG8_SB(1, 1), b3 + hstep, voffB);
            PG8_WAIT_V(6); PG8_BAR; PG8_MMA(1, 1, At, B1); PG8_BAR;
        }
        E(acc, cur, wr, wc, fr, fq);
        if (!has_next) break;
#pragma unroll
        for (int a = 0; a < 2; ++a)
#pragma unroll
            for (int b = 0; b < 2; ++b)
#pragma unroll
                for (int m = 0; m < 4; ++m)
#pragma unroll
                    for (int n = 0; n < 2; ++n) acc[a][b][m][n] = (f32x4){0.f, 0.f, 0.f, 0.f};
        cur = nxt; cA = nA; cB = nB; ++ui;
    }
    PG8_WAIT_V(0);
    if (wr == 0) PG8_BAR;
    PG8_BAR;
#undef PG8_SA
#undef PG8_SB
#undef PG8_STAGE
#undef PG8_LDA
#undef PG8_LDB
#undef PG8_MMA
#undef PG8_WAIT_V
#undef PG8_WAIT_L
#undef PG8_BAR
#undef PG8_SCHED
}
template <class Epi>
__device__ __forceinline__ void gemm_phase(LAS unsigned char* lds, const Gemm g, const Epi E) { gemm_phase(lds, g, E, Split{(int)gridDim.x, (int)blockIdx.x, 0, 1 << 30}); }
}
using pg8::Unit;
typedef f32x4 AccT[2][2][4][2];

struct EpiSwiGLU {
    static constexpr bool PERM = true;
    bf16_t* O; int ldo;
    __device__ __forceinline__ void operator()(const AccT& acc, const Unit& u, int wr, int wc, int fr, int fq) const {
        const int row0 = u.pm * 256 + wr * 64 + fr, col0 = u.pn * 128 + wc * 32 + 8 * fq;
#pragma unroll
        for (int ai = 0; ai < 2; ++ai)
#pragma unroll
            for (int m = 0; m < 4; ++m) {
                f32x4 v0, v1;
#pragma unroll
                for (int j = 0; j < 4; ++j) { v0[j] = fsilu(acc[ai][0][m][0][j]) * acc[ai][1][m][0][j]; v1[j] = fsilu(acc[ai][0][m][1][j]) * acc[ai][1][m][1][j]; }
                *(u32x4*)(O + (size_t)(row0 + ai * 128 + m * 16) * ldo + col0) = pack8(v0, v1);
            }
    }
};
struct EpiResid {
    static constexpr bool PERM = false;
    const float* base; float* out; const float* gate; float scale;
    __device__ __forceinline__ void operator()(const AccT& acc, const Unit& u, int wr, int wc, int fr, int fq) const {
        const int row0 = u.pm * 256 + wr * 64 + fr, col0 = u.pn * 256 + wc * 32 + 4 * fq;
        const float* gp = gate + (size_t)(u.pm >> 4) * (NMOD * DM) + col0;
        f32x4 gv[2][2];
#pragma unroll
        for (int bj = 0; bj < 2; ++bj)
#pragma unroll
            for (int n = 0; n < 2; ++n) gv[bj][n] = *(const f32x4*)(gp + bj * 128 + n * 16) * scale;
#pragma unroll
        for (int ai = 0; ai < 2; ++ai)
#pragma unroll
            for (int m = 0; m < 4; ++m) { const size_t off = (size_t)(row0 + ai * 128 + m * 16) * DM + col0;
#pragma unroll
                for (int bj = 0; bj < 2; ++bj)
#pragma unroll
                    for (int n = 0; n < 2; ++n) { const f32x4 bs = *(const f32x4*)(base + off + bj * 128 + n * 16); *(f32x4*)(out + off + bj * 128 + n * 16) = bs + gv[bj][n] * acc[ai][bj][m][n]; }
            }
    }
};
template <int HALFSTEP, int FIRST> struct EpiResidB {
    static constexpr bool PERM = true;
    static constexpr float scale = HALFSTEP ? 0.5f : 1.0f;
    const float* xin; bf16_t* xs; const float* gate;
    __device__ __forceinline__ void operator()(const AccT& acc, const Unit& u, int wr, int wc, int fr, int fq) const {
        const int row0 = u.pm * 256 + wr * 64 + fr, col0 = u.pn * 256 + wc * 32 + 8 * fq;
        const float* gp = gate + (size_t)(u.pm >> 4) * (NMOD * DM) + col0;
#pragma unroll
        for (int bj = 0; bj < 2; ++bj) {
            const f32x4 g0 = *(const f32x4*)(gp + bj * 128) * scale, g1 = *(const f32x4*)(gp + bj * 128 + 4) * scale;
#pragma unroll
            for (int ai = 0; ai < 2; ++ai)
#pragma unroll
                for (int m = 0; m < 4; ++m) { const size_t off = (size_t)(row0 + ai * 128 + m * 16) * DM + col0 + bj * 128;
                    f32x4 b0, b1;
                    if (FIRST) { b0 = *(const f32x4*)(xin + off); b1 = *(const f32x4*)(xin + off + 4); } else unpack8(*(const u32x4*)(xs + off), b0, b1);
                    *(u32x4*)(xs + off) = pack8(b0 + g0 * acc[ai][bj][m][0], b1 + g1 * acc[ai][bj][m][1]); }
        }
    }
};
struct EpiStore {
    static constexpr bool PERM = true;
    bf16_t* D;
    __device__ __forceinline__ void operator()(const AccT& acc, const Unit& u, int wr, int wc, int fr, int fq) const {
        const int row0 = u.pm * 256 + wr * 64 + fr, col0 = u.pn * 256 + wc * 32 + 8 * fq;
#pragma unroll
        for (int ai = 0; ai < 2; ++ai)
#pragma unroll
            for (int m = 0; m < 4; ++m)
#pragma unroll
                for (int bj = 0; bj < 2; ++bj) *(u32x4*)(D + (size_t)(row0 + ai * 128 + m * 16) * DM + col0 + bj * 128) = pack8(acc[ai][bj][m][0], acc[ai][bj][m][1]);
    }
};
struct EpiMixA {
    static constexpr bool PERM = true;
    bf16_t* P; const float* oml;
    template <int SEC> __device__ __forceinline__ void body(const AccT& acc, const Unit& u, int wr, int wc, int fr, int fq) const {
        const int row0 = u.pm * 256 + wr * 64 + fr, col0 = (u.pn & 3) * 256 + wc * 32 + 8 * fq;
        bf16_t* base = P + (size_t)SEC * (SLOT / 2);
#pragma unroll
        for (int bj = 0; bj < 2; ++bj) {
            f32x4 l0 = (f32x4){0.f, 0.f, 0.f, 0.f}, l1 = l0;
            if (SEC == 1) { l0 = *(const f32x4*)(oml + col0 + bj * 128); l1 = *(const f32x4*)(oml + col0 + bj * 128 + 4); }
#pragma unroll
            for (int ai = 0; ai < 2; ++ai)
#pragma unroll
                for (int m = 0; m < 4; ++m) {
                    f32x4 v0 = acc[ai][bj][m][0], v1 = acc[ai][bj][m][1];
                    if (SEC == 0) {
#pragma unroll
                        for (int j = 0; j < 4; ++j) { v0[j] = fsilu(v0[j]) * 0.08838834764831845f; v1[j] = fsilu(v1[j]) * 0.08838834764831845f; }
                    } else if (SEC == 3) {
#pragma unroll
                        for (int j = 0; j < 4; ++j) { v0[j] = fsilu(v0[j]); v1[j] = fsilu(v1[j]); }
                    } else if (SEC == 1) {
#pragma unroll
                        for (int j = 0; j < 4; ++j) { v0[j] = l0[j] * fsigmoid(-v0[j]); v1[j] = l1[j] * fsigmoid(-v1[j]); }
                    }
                    *(u32x4*)(base + (size_t)(row0 + ai * 128 + m * 16) * DM + col0 + bj * 128) = pack8(v0, v1);
                }
        }
    }
    __device__ __forceinline__ void operator()(const AccT& acc, const Unit& u, int wr, int wc, int fr, int fq) const {
        const int sec = u.pn >> 2;
        if (sec == 0) body<0>(acc, u, wr, wc, fr, fq); else if (sec == 1) body<1>(acc, u, wr, wc, fr, fq); else if (sec == 2) body<2>(acc, u, wr, wc, fr, fq); else body<3>(acc, u, wr, wc, fr, fq);
    }
};
struct EpiMixB {
    static constexpr bool PERM = true;
    bf16_t* ug; bf16_t* sga; bf16_t* sgb;
    __device__ __forceinline__ void operator()(const AccT& acc, const Unit& u, int wr, int wc, int fr, int fq) const {
        const int pn = u.pn; const int row0 = u.pm * 256 + wr * 64 + fr;
        if (pn < 8) {
            const int col0 = pn * 128 + wc * 32 + 8 * fq;
#pragma unroll
            for (int ai = 0; ai < 2; ++ai)
#pragma unroll
                for (int m = 0; m < 4; ++m) {
                    f32x4 v0, v1;
#pragma unroll
                    for (int j = 0; j < 4; ++j) { v0[j] = acc[ai][0][m][0][j] * fsigmoid(acc[ai][1][m][0][j]); v1[j] = acc[ai][0][m][1][j] * fsigmoid(acc[ai][1][m][1][j]); }
                    *(u32x4*)(ug + (size_t)(row0 + ai * 128 + m * 16) * DM + col0) = pack8(v0, v1);
                }
        } else {
            bf16_t* base = pn < 12 ? sga : sgb; const int col0 = (pn & 3) * 256 + wc * 32 + 8 * fq;
#pragma unroll
            for (int ai = 0; ai < 2; ++ai)
#pragma unroll
                for (int m = 0; m < 4; ++m)
#pragma unroll
                    for (int bj = 0; bj < 2; ++bj) {
                        f32x4 v0 = acc[ai][bj][m][0], v1 = acc[ai][bj][m][1];
#pragma unroll
                        for (int j = 0; j < 4; ++j) { v0[j] = fsigmoid(v0[j]); v1[j] = fsigmoid(v1[j]); }
                        *(u32x4*)(base + (size_t)(row0 + ai * 128 + m * 16) * DM + col0 + bj * 128) = pack8(v0, v1);
                    }
        }
    }
};
template <int MODE> struct EpiGate {
    static constexpr bool PERM = true;
    bf16_t* G; const bf16_t* Mprev;
    __device__ __forceinline__ void operator()(const AccT& acc, const Unit& u, int wr, int wc, int fr, int fq) const {
        const int row0 = u.pm * 256 + wr * 64 + fr, col0 = u.pn * 256 + wc * 32 + 8 * fq;
#pragma unroll
        for (int ai = 0; ai < 2; ++ai)
#pragma unroll
            for (int m = 0; m < 4; ++m)
#pragma unroll
                for (int bj = 0; bj < 2; ++bj) {
                    const size_t off = (size_t)(row0 + ai * 128 + m * 16) * DM + col0 + bj * 128;
                    f32x4 g0, g1; unpack8(*(const u32x4*)(G + off), g0, g1);
                    f32x4 v0 = g0 * acc[ai][bj][m][0], v1 = g1 * acc[ai][bj][m][1];
                    if (MODE == 1) { f32x4 p0, p1; unpack8(*(const u32x4*)(Mprev + off), p0, p1); v0 += p0; v1 += p1; }
                    *(u32x4*)(G + off) = pack8(v0, v1);
                }
    }
};

__device__ __forceinline__ int wcol_map(int n, int mode) {
    if (mode == 1) { const int j = n >> 8, r = n & 255; return r < 128 ? 128 * j + r : DFF + 128 * j + (r - 128); }
    if (mode == 2 && n >= 4096 && n < 6144) { const int q = n - 4096, j = q >> 8, r = q & 255; return r < 128 ? 4096 + 128 * j + r : 5120 + 128 * j + (r - 128); }
    return n;
}
__device__ void conv_weight(LAS unsigned char* lds, const float* src, bf16_t* dst, int K, int N, int mode, int first, int step) {
    LAS float* tile = (LAS float*)lds;
    const int tid = threadIdx.x; const int nkt = K >> 6, nnt = N >> 6, ntiles = nkt * nnt;
    const int r = tid >> 4, c4 = (tid & 15) * 4;
    int t = first; f32x4 v0 = (f32x4){0.f, 0.f, 0.f, 0.f}, v1 = v0;
    if (t < ntiles) { const int k0 = (t % nkt) * 64, sc0 = wcol_map((t / nkt) * 64, mode);
        v0 = *(const f32x4*)(src + (size_t)(k0 + r) * N + sc0 + c4); v1 = *(const f32x4*)(src + (size_t)(k0 + r + 32) * N + sc0 + c4); }
    while (t < ntiles) {
        const int k0 = (t % nkt) * 64, n0 = (t / nkt) * 64; const int tn = t + step;
        f32x4 p0 = v0, p1 = v1;
        if (tn < ntiles) { const int kn = (tn % nkt) * 64, scn = wcol_map((tn / nkt) * 64, mode);
            p0 = *(const f32x4*)(src + (size_t)(kn + r) * N + scn + c4); p1 = *(const f32x4*)(src + (size_t)(kn + r + 32) * N + scn + c4); }
        tile[r * 65 + c4 + 0] = v0[0]; tile[r * 65 + c4 + 1] = v0[1]; tile[r * 65 + c4 + 2] = v0[2]; tile[r * 65 + c4 + 3] = v0[3];
        tile[(r + 32) * 65 + c4 + 0] = v1[0]; tile[(r + 32) * 65 + c4 + 1] = v1[1]; tile[(r + 32) * 65 + c4 + 2] = v1[2]; tile[(r + 32) * 65 + c4 + 3] = v1[3];
        __syncthreads();
        { const int n = tid >> 3, k8 = (tid & 7) * 8; f32x4 a, b;
#pragma unroll
          for (int j = 0; j < 4; ++j) { a[j] = tile[(k8 + j) * 65 + n]; b[j] = tile[(k8 + 4 + j) * 65 + n]; }
          *(u32x4*)(dst + (size_t)(n0 + n) * K + k0 + k8) = pack8(a, b); }
        __syncthreads();
        v0 = p0; v1 = p1; t = tn;
    }
}
__device__ void mod_phase(LAS unsigned char* lds, const float* c, const float* ada_w, const float* ada_b, const float* hgrn_lb, float* mod, float* oml) {
    LAS float* cs = (LAS float*)lds;
    LAS float* red = (LAS float*)(lds + 32768);
    const int tid = threadIdx.x;
    constexpr int NT = (NMOD * DM) / 36;
    for (int i = tid; i < 8 * DM; i += 512) cs[i] = fsilu(c[i]);
    __syncthreads();
    for (int task = blockIdx.x; task < NT; task += gridDim.x) {
        const int j0 = task * 36;
        if (tid < 288) {
            const int q = tid % 9, kg = tid / 9;
            f32x4 acc[8];
#pragma unroll
            for (int b = 0; b < 8; ++b) acc[b] = (f32x4){0.f, 0.f, 0.f, 0.f};
            const float* wp = ada_w + (size_t)(kg * 32) * (NMOD * DM) + j0 + 4 * q;
#pragma unroll
            for (int k8 = 0; k8 < 32; k8 += 8) {
                f32x4 w[8];
#pragma unroll
                for (int i = 0; i < 8; ++i) w[i] = *(const f32x4*)(wp + (size_t)(k8 + i) * (NMOD * DM));
#pragma unroll
                for (int b = 0; b < 8; ++b) { const f32x4 c0 = *(const LAS f32x4*)(cs + b * DM + kg * 32 + k8), c1 = *(const LAS f32x4*)(cs + b * DM + kg * 32 + k8 + 4);
                    acc[b] += c0[0] * w[0] + c0[1] * w[1] + c0[2] * w[2] + c0[3] * w[3] + c1[0] * w[4] + c1[1] * w[5] + c1[2] * w[6] + c1[3] * w[7]; }
            }
#pragma unroll
            for (int b = 0; b < 8; ++b) { red[(kg * 8 + b) * 36 + 4 * q + 0] = acc[b][0]; red[(kg * 8 + b) * 36 + 4 * q + 1] = acc[b][1]; red[(kg * 8 + b) * 36 + 4 * q + 2] = acc[b][2]; red[(kg * 8 + b) * 36 + 4 * q + 3] = acc[b][3]; }
        }
        __syncthreads();
        if (tid < 288) { const int b = tid / 36, col = tid % 36; float sacc = ada_b[j0 + col];
#pragma unroll
            for (int g = 0; g < 32; ++g) sacc += red[(g * 8 + b) * 36 + col];
            mod[(size_t)b * (NMOD * DM) + j0 + col] = sacc; }
        __syncthreads();
    }
    if (blockIdx.x == gridDim.x - 1) {
        for (int d = tid; d < DM; d += 512) { const float a0 = hgrn_lb[d], a1 = hgrn_lb[DM + d]; const float lb = 1.0f / (1.0f + expf(a1 - a0)); oml[d] = 1.0f - lb; }
    }
}
__device__ void norm_mod_phase(const float* x, const float* gw, const float* mod, int shidx, bf16_t* h) {
    const int wid = threadIdx.x >> 6, lane = threadIdx.x & 63; const int nw = gridDim.x * 8;
    for (int base = (blockIdx.x * 8 + wid) * 16; base < MTOK; base += nw * 16) {
        const float* mp = mod + (size_t)(base >> 12) * (NMOD * DM) + shidx * DM;
        f32x4 wv[4], sv[4];
#pragma unroll
        for (int i = 0; i < 4; ++i) { const int c = i * 256 + lane * 4; wv[i] = *(const f32x4*)(gw + c) * (*(const f32x4*)(mp + DM + c) + 1.0f); sv[i] = *(const f32x4*)(mp + c); }
        for (int r0 = 0; r0 < 16; r0 += 2) {
            f32x4 v[2][4]; float ss[2];
#pragma unroll
            for (int u = 0; u < 2; ++u)
#pragma unroll
                for (int i = 0; i < 4; ++i) v[u][i] = *(const f32x4*)(x + (size_t)(base + r0 + u) * DM + i * 256 + lane * 4);
#pragma unroll
            for (int u = 0; u < 2; ++u) { float t = 0.f;
#pragma unroll
                for (int i = 0; i < 4; ++i) t += v[u][i][0] * v[u][i][0] + v[u][i][1] * v[u][i][1] + v[u][i][2] * v[u][i][2] + v[u][i][3] * v[u][i][3];
#pragma unroll
                for (int o = 32; o >= 1; o >>= 1) t += __shfl_xor(t, o);
                ss[u] = rsqrtf(t * (1.0f / DM) + EPS); }
#pragma unroll
            for (int u = 0; u < 2; ++u)
#pragma unroll
                for (int i = 0; i < 4; ++i) { const f32x4 y = v[u][i] * ss[u] * wv[i] + sv[i]; u32x2 w; w.x = cvt_pk_bf16(y[0], y[1]); w.y = cvt_pk_bf16(y[2], y[3]);
                    *(u32x2*)(h + (size_t)(base + r0 + u) * DM + i * 256 + lane * 4) = w; }
        }
    }
}
__device__ void norm_mod_phase_b(const bf16_t* x, const float* gw, const float* mod, int shidx, bf16_t* h) {
    const int wid = threadIdx.x >> 6, lane = threadIdx.x & 63; const int nw = gridDim.x * 8;
    for (int base = (blockIdx.x * 8 + wid) * 16; base < MTOK; base += nw * 16) {
        const float* mp = mod + (size_t)(base >> 12) * (NMOD * DM) + shidx * DM;
        f32x4 wv[4], sv[4];
#pragma unroll
        for (int i = 0; i < 4; ++i) { const int c = (i >> 1) * 512 + lane * 8 + (i & 1) * 4; wv[i] = *(const f32x4*)(gw + c) * (*(const f32x4*)(mp + DM + c) + 1.0f); sv[i] = *(const f32x4*)(mp + c); }
        for (int r0 = 0; r0 < 16; r0 += 2) {
            u32x4 raw[2][2]; f32x4 v[2][4]; float ss[2];
#pragma unroll
            for (int u = 0; u < 2; ++u) { const bf16_t* xr = x + (size_t)(base + r0 + u) * DM; raw[u][0] = *(const u32x4*)(xr + lane * 8); raw[u][1] = *(const u32x4*)(xr + 512 + lane * 8); }
#pragma unroll
            for (int u = 0; u < 2; ++u) { unpack8(raw[u][0], v[u][0], v[u][1]); unpack8(raw[u][1], v[u][2], v[u][3]); float t = 0.f;
#pragma unroll
                for (int i = 0; i < 4; ++i) t += v[u][i][0] * v[u][i][0] + v[u][i][1] * v[u][i][1] + v[u][i][2] * v[u][i][2] + v[u][i][3] * v[u][i][3];
#pragma unroll
                for (int o = 32; o >= 1; o >>= 1) t += __shfl_xor(t, o);
                ss[u] = rsqrtf(t * (1.0f / DM) + EPS); }
#pragma unroll
            for (int u = 0; u < 2; ++u) { f32x4 y[4];
#pragma unroll
                for (int i = 0; i < 4; ++i) y[i] = v[u][i] * ss[u] * wv[i] + sv[i];
                bf16_t* hr = h + (size_t)(base + r0 + u) * DM; *(u32x4*)(hr + lane * 8) = pack8(y[0], y[1]); *(u32x4*)(hr + 512 + lane * 8) = pack8(y[2], y[3]); }
        }
    }
}
__device__ void final_norm_phase_b(const bf16_t* x, const bf16_t* D, const float* gate, float scale, const float* gw, float* out) {
    const int wid = threadIdx.x >> 6, lane = threadIdx.x & 63; const int nw = gridDim.x * 8;
    f32x4 gv[4];
#pragma unroll
    for (int i = 0; i < 4; ++i) gv[i] = *(const f32x4*)(gw + (i >> 1) * 512 + lane * 8 + (i & 1) * 4);
    for (int base = (blockIdx.x * 8 + wid) * 16; base < MTOK; base += nw * 16) {
        const float* gp = gate + (size_t)(base >> 12) * (NMOD * DM);
        f32x4 gt[4];
#pragma unroll
        for (int i = 0; i < 4; ++i) gt[i] = *(const f32x4*)(gp + (i >> 1) * 512 + lane * 8 + (i & 1) * 4) * scale;
        for (int r0 = 0; r0 < 16; r0 += 2) {
            u32x4 raw[2][2], rd[2][2]; f32x4 v[2][4]; float ss[2];
#pragma unroll
            for (int u = 0; u < 2; ++u) { const size_t ro = (size_t)(base + r0 + u) * DM; raw[u][0] = *(const u32x4*)(x + ro + lane * 8); raw[u][1] = *(const u32x4*)(x + ro + 512 + lane * 8);
                rd[u][0] = *(const u32x4*)(D + ro + lane * 8); rd[u][1] = *(const u32x4*)(D + ro + 512 + lane * 8); }
#pragma unroll
            for (int u = 0; u < 2; ++u) { f32x4 dv[4]; unpack8(raw[u][0], v[u][0], v[u][1]); unpack8(raw[u][1], v[u][2], v[u][3]); unpack8(rd[u][0], dv[0], dv[1]); unpack8(rd[u][1], dv[2], dv[3]);
                float t = 0.f;
#pragma unroll
                for (int i = 0; i < 4; ++i) { v[u][i] += gt[i] * dv[i]; t += v[u][i][0] * v[u][i][0] + v[u][i][1] * v[u][i][1] + v[u][i][2] * v[u][i][2] + v[u][i][3] * v[u][i][3]; }
#pragma unroll
                for (int o = 32; o >= 1; o >>= 1) t += __shfl_xor(t, o);
                ss[u] = rsqrtf(t * (1.0f / DM) + EPS); }
#pragma unroll
            for (int u = 0; u < 2; ++u)
#pragma unroll
                for (int i = 0; i < 4; ++i) *(f32x4*)(out + (size_t)(base + r0 + u) * DM + (i >> 1) * 512 + lane * 8 + (i & 1) * 4) = v[u][i] * ss[u] * gv[i];
        }
    }
}
__device__ void final_norm_phase(float* x, const float* gw) {
    const int wid = threadIdx.x >> 6, lane = threadIdx.x & 63;
    for (int row = blockIdx.x * 8 + wid; row < MTOK; row += gridDim.x * 8) {
        float* xr = x + (size_t)row * DM; f32x4 v[4]; float ss = 0.f;
#pragma unroll
        for (int i = 0; i < 4; ++i) { v[i] = *(const f32x4*)(xr + i * 256 + lane * 4); ss += v[i][0] * v[i][0] + v[i][1] * v[i][1] + v[i][2] * v[i][2] + v[i][3] * v[i][3]; }
#pragma unroll
        for (int o = 32; o >= 1; o >>= 1) ss += __shfl_xor(ss, o);
        const float r = rsqrtf(ss * (1.0f / DM) + EPS);
#pragma unroll
        for (int i = 0; i < 4; ++i) { const int c = i * 256 + lane * 4; const f32x4 g = *(const f32x4*)(gw + c); *(f32x4*)(xr + c) = v[i] * r * g; }
    }
}
__device__ void conv_phase(LAS unsigned char* lds, const bf16_t* ug, const float* cw, const float* cb, const float* lng, const float* lnb, bf16_t* out, int first, int step) {
    constexpr int T = 32, ROWS = T + 30;
    LAS unsigned* tile = (LAS unsigned*)lds;
    LAS float* wred = (LAS float*)(lds + ROWS * 2048);
    LAS float* stat = (LAS float*)(lds + ROWS * 2048 + 1024);
    const int tid = threadIdx.x, wid = tid >> 6, lane = tid & 63, c0 = tid * 2;
    f32x2 w[31];
#pragma unroll
    for (int j = 0; j < 31; ++j) w[j] = *(const f32x2*)(cw + j * DM + c0);
    const f32x2 bias = *(const f32x2*)(cb + c0), lg = *(const f32x2*)(lng + c0), lb = *(const f32x2*)(lnb + c0);
    for (int blk = first; blk < MTOK / T; blk += step) {
        const int tok0 = blk * T, tseq = tok0 & (SEQ - 1);
#pragma unroll
        for (int k = 0; k < 16; ++k) { const int idx = tid + 512 * k;
            if (idx < ROWS * 128) { const int row = idx >> 7, pc = idx & 127; u32x4 v = (u32x4){0u, 0u, 0u, 0u};
                if (tseq - 30 + row >= 0) v = *(const u32x4*)(ug + (size_t)(tok0 - 30 + row) * DM + pc * 8);
                *(LAS u32x4*)(tile + row * 512 + pc * 4) = v; } }
        __syncthreads();
#pragma unroll 1
        for (int half = 0; half < 2; ++half) {
            const LAS unsigned* trow = tile + (16 * half) * 512 + tid;
            f32x2 acc[16];
#pragma unroll
            for (int t = 0; t < 16; ++t) acc[t] = bias;
#pragma unroll
            for (int i = 0; i < 46; ++i) {
                const unsigned raw = trow[i * 512];
                const f32x2 uv = (f32x2){bflo(raw), bfhi(raw)};
#pragma unroll
                for (int t = 0; t < 16; ++t) { const int j = i - t; if (j >= 0 && j <= 30) acc[t] += w[j] * uv; }
            }
            float v[32];
#pragma unroll
            for (int t = 0; t < 16; ++t) { v[t] = acc[t].x + acc[t].y; v[16 + t] = acc[t].x * acc[t].x + acc[t].y * acc[t].y; }
#pragma unroll
            for (int i = 0; i < 32; ++i) v[i] += __shfl_xor(v[i], 32);
#pragma unroll
            for (int i = 0; i < 16; ++i) { const bool up = (lane & 16) != 0; const float send = up ? v[i] : v[i + 16], keep = up ? v[i + 16] : v[i]; v[i] = keep + __shfl_xor(send, 16); }
#pragma unroll
            for (int i = 0; i < 8; ++i) { const bool up = (lane & 8) != 0; const float send = up ? v[i] : v[i + 8], keep = up ? v[i + 8] : v[i]; v[i] = keep + __shfl_xor(send, 8); }
#pragma unroll
            for (int i = 0; i < 4; ++i) { const bool up = (lane & 4) != 0; const float send = up ? v[i] : v[i + 4], keep = up ? v[i + 4] : v[i]; v[i] = keep + __shfl_xor(send, 4); }
#pragma unroll
            for (int i = 0; i < 2; ++i) { const bool up = (lane & 2) != 0; const float send = up ? v[i] : v[i + 2], keep = up ? v[i + 2] : v[i]; v[i] = keep + __shfl_xor(send, 2); }
            { const bool up = (lane & 1) != 0; const float send = up ? v[0] : v[1], keep = up ? v[1] : v[0]; v[0] = keep + __shfl_xor(send, 1); }
            if (lane < 32) wred[wid * 32 + lane] = v[0];
            __syncthreads();
            if (tid < 16) { float s1 = 0.f, s2 = 0.f;
#pragma unroll
                for (int g = 0; g < 8; ++g) { s1 += wred[g * 32 + tid]; s2 += wred[g * 32 + 16 + tid]; }
                const float mean = s1 * (1.0f / DM); const float var = fmaxf(s2 * (1.0f / DM) - mean * mean, 0.f);
                stat[tid] = mean; stat[16 + tid] = rsqrtf(var + EPS); }
            __syncthreads();
#pragma unroll
            for (int t = 0; t < 16; ++t) { const float mean = stat[t], rs = stat[16 + t];
                const float y0 = (acc[t].x - mean) * rs * lg.x + lb.x, y1 = (acc[t].y - mean) * rs * lg.y + lb.y;
                tile[(16 * half + t) * 512 + tid] = cvt_pk_bf16(fsilu(y0), fsilu(y1)); }
            __syncthreads();
        }
#pragma unroll
        for (int k = 0; k < 8; ++k) { const int idx = tid + 512 * k, row = idx >> 7, pc = idx & 127;
            *(u32x4*)(out + (size_t)(tok0 + row) * DM + pc * 8) = *(const LAS u32x4*)(tile + row * 512 + pc * 4); }
        __syncthreads();
    }
}

constexpr int QS_LD = 136, KT_LD = 72;
constexpr int H_QS = 0, H_KS = H_QS + 64 * QS_LD * 2, H_KT = H_KS + 64 * QS_LD * 2, H_VT = H_KT + 128 * KT_LD * 2, H_ST = H_VT + 128 * KT_LD * 2,
              H_AT = H_ST + 128 * QS_LD * 2, H_EL = H_AT + 64 * KT_LD * 2, H_SSQ = H_EL + 128 * 4, H_OS = H_SSQ + 64 * 2 * 4, H_END = H_OS + 64 * QS_LD * 2;
static_assert(H_END <= LDS_MAIN, "hgrn lds");
template <int N> __device__ __forceinline__ float row_shr_or_one(float x) {
    return __builtin_bit_cast(float, __builtin_amdgcn_update_dpp(0x3f800000, __builtin_bit_cast(int, x), 0x110 + N, 0xf, 0xf, false));
}
__device__ __forceinline__ void hgrn_unit(LAS unsigned char* lds, int bh, const bf16_t* qh, const bf16_t* kk, bf16_t* vo, const bf16_t* sog, const float* hg) {
    LAS bf16_t* Qs = (LAS bf16_t*)(lds + H_QS); LAS bf16_t* Ks = (LAS bf16_t*)(lds + H_KS); LAS bf16_t* KT = (LAS bf16_t*)(lds + H_KT);
    LAS bf16_t* VT = (LAS bf16_t*)(lds + H_VT); LAS bf16_t* ST = (LAS bf16_t*)(lds + H_ST); LAS bf16_t* AT = (LAS bf16_t*)(lds + H_AT);
    LAS float* elast = (LAS float*)(lds + H_EL); LAS float* ssq = (LAS float*)(lds + H_SSQ); LAS bf16_t* Os = (LAS bf16_t*)(lds + H_OS);
    const int tid = threadIdx.x, wid = tid >> 6, lane = tid & 63, fr = lane & 15, fq = lane >> 4;
    const int b = bh >> 3, h = bh & 7; const size_t tokb = (size_t)b * SEQ;
    const int ti = wid >> 1, vh = wid & 1;
    const bf16_t* qp = qh + (tokb + lane) * DM + h * 128 + 16 * wid;
    const bf16_t* kp = kk + (tokb + lane) * DM + h * 128 + 16 * wid;
    const int vs = tid >> 3, v16 = (tid & 7) * 16;
    bf16_t* vp = vo + (tokb + vs) * DM + h * 128 + v16;
    const bf16_t* sp = sog + (tokb + vs) * DM + h * 128 + v16;
    float gq[4];
#pragma unroll
    for (int jj = 0; jj < 4; ++jj) gq[jj] = hg[h * 128 + 64 * vh + 16 * jj + fr];
    for (int i = tid; i < 128 * QS_LD; i += 512) ST[i] = 0;
    f32x4 sacc[8];
#pragma unroll
    for (int vi = 0; vi < 8; ++vi) sacc[vi] = (f32x4){0.f, 0.f, 0.f, 0.f};
    u32x4 kr0 = *(const u32x4*)kp, kr1 = *(const u32x4*)(kp + 8), qr0 = *(const u32x4*)qp, qr1 = *(const u32x4*)(qp + 8);
    u32x4 vr0 = *(const u32x4*)vp, vr1 = *(const u32x4*)(vp + 8);
    __syncthreads();
    for (int c = 0; c < SEQ / 64; ++c) {
        const size_t cadv = (size_t)c * 64 * DM;
        const u32x4 sg0 = *(const u32x4*)(sp + cadv), sg1 = *(const u32x4*)(sp + cadv + 8);
        { f32x4 kf[4], qf[4]; unpack8(kr0, kf[0], kf[1]); unpack8(kr1, kf[2], kf[3]); unpack8(qr0, qf[0], qf[1]); unpack8(qr1, qf[2], qf[3]);
          const int row = lane >> 4;
          unsigned qw[8], kw[8]; f32x4 plast[4];
#pragma unroll
          for (int g4 = 0; g4 < 4; ++g4) {
              f32x4 e4, r4;
#pragma unroll
              for (int j = 0; j < 4; ++j) {
                  float x = 1.0f - kf[g4][j];
                  x *= row_shr_or_one<1>(x); x *= row_shr_or_one<2>(x); x *= row_shr_or_one<4>(x); x *= row_shr_or_one<8>(x);
                  const int xi = __builtin_bit_cast(int, x);
                  const float r0 = __builtin_bit_cast(float, __builtin_amdgcn_readlane(xi, 15)), r1 = __builtin_bit_cast(float, __builtin_amdgcn_readlane(xi, 31)),
                              r2 = __builtin_bit_cast(float, __builtin_amdgcn_readlane(xi, 47)), r3 = __builtin_bit_cast(float, __builtin_amdgcn_readlane(xi, 63));
                  const float m01 = r0 * r1, m012 = m01 * r2;
                  const float mult = row == 0 ? 1.0f : (row == 1 ? r0 : (row == 2 ? m01 : m012));
                  x *= mult;
                  e4[j] = x; r4[j] = __builtin_amdgcn_rcpf(x); plast[g4][j] = m012 * r3; }
              const f32x4 qs = qf[g4] * e4, ks = kf[g4] * r4;
              qw[2 * g4] = cvt_pk_bf16(qs[0], qs[1]); qw[2 * g4 + 1] = cvt_pk_bf16(qs[2], qs[3]);
              kw[2 * g4] = cvt_pk_bf16(ks[0], ks[1]); kw[2 * g4 + 1] = cvt_pk_bf16(ks[2], ks[3]); }
          *(LAS u32x4*)(Qs + lane * QS_LD + 16 * wid) = (u32x4){qw[0], qw[1], qw[2], qw[3]}; *(LAS u32x4*)(Qs + lane * QS_LD + 16 * wid + 8) = (u32x4){qw[4], qw[5], qw[6], qw[7]};
          *(LAS u32x4*)(Ks + lane * QS_LD + 16 * wid) = (u32x4){kw[0], kw[1], kw[2], kw[3]}; *(LAS u32x4*)(Ks + lane * QS_LD + 16 * wid + 8) = (u32x4){kw[4], kw[5], kw[6], kw[7]};
#pragma unroll
          for (int i = 0; i < 8; ++i) { KT[(16 * wid + 2 * i) * KT_LD + lane] = (bf16_t)(kw[i] & 0xffffu); KT[(16 * wid + 2 * i + 1) * KT_LD + lane] = (bf16_t)(kw[i] >> 16); }
          if (lane == 0) {
#pragma unroll
              for (int g4 = 0; g4 < 4; ++g4) *(LAS f32x4*)(elast + 16 * wid + 4 * g4) = plast[g4]; } }
        { VT[(v16 + 0) * KT_LD + vs] = (bf16_t)(vr0.x & 0xffffu); VT[(v16 + 1) * KT_LD + vs] = (bf16_t)(vr0.x >> 16);
          VT[(v16 + 2) * KT_LD + vs] = (bf16_t)(vr0.y & 0xffffu); VT[(v16 + 3) * KT_LD + vs] = (bf16_t)(vr0.y >> 16);
          VT[(v16 + 4) * KT_LD + vs] = (bf16_t)(vr0.z & 0xffffu); VT[(v16 + 5) * KT_LD + vs] = (bf16_t)(vr0.z >> 16);
          VT[(v16 + 6) * KT_LD + vs] = (bf16_t)(vr0.w & 0xffffu); VT[(v16 + 7) * KT_LD + vs] = (bf16_t)(vr0.w >> 16);
          VT[(v16 + 8) * KT_LD + vs] = (bf16_t)(vr1.x & 0xffffu); VT[(v16 + 9) * KT_LD + vs] = (bf16_t)(vr1.x >> 16);
          VT[(v16 + 10) * KT_LD + vs] = (bf16_t)(vr1.y & 0xffffu); VT[(v16 + 11) * KT_LD + vs] = (bf16_t)(vr1.y >> 16);
          VT[(v16 + 12) * KT_LD + vs] = (bf16_t)(vr1.z & 0xffffu); VT[(v16 + 13) * KT_LD + vs] = (bf16_t)(vr1.z >> 16);
          VT[(v16 + 14) * KT_LD + vs] = (bf16_t)(vr1.w & 0xffffu); VT[(v16 + 15) * KT_LD + vs] = (bf16_t)(vr1.w >> 16); }
        if (c + 1 < SEQ / 64) {
            const size_t adv = cadv + (size_t)64 * DM;
            kr0 = *(const u32x4*)(kp + adv); kr1 = *(const u32x4*)(kp + adv + 8); qr0 = *(const u32x4*)(qp + adv); qr1 = *(const u32x4*)(qp + adv + 8);
            vr0 = *(const u32x4*)(vp + adv); vr1 = *(const u32x4*)(vp + adv + 8);
        }
        __syncthreads();
#pragma unroll
        for (int jj = 0; jj < 2; ++jj) {
            const int sj = 2 * (wid & 1) + jj;
            f32x4 a4 = (f32x4){0.f, 0.f, 0.f, 0.f};
            if (sj <= ti) {
#pragma unroll
                for (int kd = 0; kd < 4; ++kd) {
                    const bf16x8 av = *(const LAS bf16x8*)(Qs + (16 * ti + fr) * QS_LD + 32 * kd + 8 * fq);
                    const bf16x8 bv = *(const LAS bf16x8*)(Ks + (16 * sj + fr) * QS_LD + 32 * kd + 8 * fq);
                    a4 = __builtin_amdgcn_mfma_f32_16x16x32_bf16(av, bv, a4, 0, 0, 0);
                }
            }
#pragma unroll
            for (int j = 0; j < 4; ++j) { const int t = 16 * ti + 4 * fq + j, s_ = 16 * sj + fr; AT[t * KT_LD + s_] = (s_ <= t) ? f2bf(a4[j]) : (bf16_t)0; }
        }
        __syncthreads();
        f32x4 o4[4];
        { bf16x8 af[2], qf[4];
#pragma unroll
          for (int ks = 0; ks < 2; ++ks) af[ks] = *(const LAS bf16x8*)(AT + (16 * ti + fr) * KT_LD + 32 * ks + 8 * fq);
#pragma unroll
          for (int kd = 0; kd < 4; ++kd) qf[kd] = *(const LAS bf16x8*)(Qs + (16 * ti + fr) * QS_LD + 32 * kd + 8 * fq);
#pragma unroll
          for (int jj = 0; jj < 4; ++jj) { const int vrow = 64 * vh + 16 * jj + fr; f32x4 t4 = (f32x4){0.f, 0.f, 0.f, 0.f};
#pragma unroll
              for (int ks = 0; ks < 2; ++ks) t4 = __builtin_amdgcn_mfma_f32_16x16x32_bf16(af[ks], *(const LAS bf16x8*)(VT + vrow * KT_LD + 32 * ks + 8 * fq), t4, 0, 0, 0);
#pragma unroll
              for (int kd = 0; kd < 4; ++kd) t4 = __builtin_amdgcn_mfma_f32_16x16x32_bf16(qf[kd], *(const LAS bf16x8*)(ST + vrow * QS_LD + 32 * kd + 8 * fq), t4, 0, 0, 0);
              o4[jj] = t4; } }
#pragma unroll
        for (int j = 0; j < 4; ++j) { float p = (o4[0][j] * o4[0][j] + o4[1][j] * o4[1][j]) + (o4[2][j] * o4[2][j] + o4[3][j] * o4[3][j]);
            p += __shfl_xor(p, 1); p += __shfl_xor(p, 2); p += __shfl_xor(p, 4); p += __shfl_xor(p, 8);
            if (fr == 0) ssq[(16 * ti + 4 * fq + j) * 2 + vh] = p; }
        { bf16x8 kf2[2];
#pragma unroll
          for (int ks = 0; ks < 2; ++ks) kf2[ks] = *(const LAS bf16x8*)(KT + (16 * wid + fr) * KT_LD + 32 * ks + 8 * fq);
          const f32x4 el = *(const LAS f32x4*)(elast + 16 * wid + 4 * fq);
#pragma unroll
          for (int vi = 0; vi < 8; ++vi) {
#pragma unroll
              for (int ks = 0; ks < 2; ++ks) sacc[vi] = __builtin_amdgcn_mfma_f32_16x16x32_bf16(kf2[ks], *(const LAS bf16x8*)(VT + (16 * vi + fr) * KT_LD + 32 * ks + 8 * fq), sacc[vi], 0, 0, 0);
              sacc[vi] = sacc[vi] * el; } }
        __syncthreads();
#pragma unroll
        for (int j = 0; j < 4; ++j) { const int t = 16 * ti + 4 * fq + j; const float r = rsqrtf((ssq[t * 2] + ssq[t * 2 + 1]) * (1.0f / 128.0f) + EPS);
#pragma unroll
            for (int jj = 0; jj < 4; ++jj) Os[t * QS_LD + 64 * vh + 16 * jj + fr] = f2bf(o4[jj][j] * r * gq[jj]); }
#pragma unroll
        for (int vi = 0; vi < 8; ++vi) { u32x2 w; w.x = cvt_pk_bf16(sacc[vi][0], sacc[vi][1]); w.y = cvt_pk_bf16(sacc[vi][2], sacc[vi][3]);
            *(LAS u32x2*)(ST + (16 * vi + fr) * QS_LD + 16 * wid + 4 * fq) = w; }
        __syncthreads();
        { f32x4 ov[4], gv[4]; const u32x4 ow0 = *(const LAS u32x4*)(Os + vs * QS_LD + v16), ow1 = *(const LAS u32x4*)(Os + vs * QS_LD + v16 + 8); unpack8(ow0, ov[0], ov[1]); unpack8(ow1, ov[2], ov[3]);
          unpack8(sg0, gv[0], gv[1]); unpack8(sg1, gv[2], gv[3]);
          *(u32x4*)(vp + cadv) = pack8(ov[0] * gv[0], ov[1] * gv[1]); *(u32x4*)(vp + cadv + 8) = pack8(ov[2] * gv[2], ov[3] * gv[3]); }
    }
    __syncthreads();
}

#define XB_TMO      128
#define XB_XCNT(j)  (256  + 64 * (j))
#define XB_XSUB(j)  (1280 + 64 * (j))
#define XB_XGEN(j)  (2304 + 64 * (j))
#define XB_TOP      3328
#define XB_TOPGEN   3392
#define XCD_BAR_WORDS 3456
#define XB_SPIN_CAP (1u << 18)
__device__ __forceinline__ unsigned xb_ld(unsigned* p)              { return __hip_atomic_load(p, __ATOMIC_RELAXED, __HIP_MEMORY_SCOPE_AGENT); }
__device__ __forceinline__ unsigned xb_add(unsigned* p, unsigned v) { return __hip_atomic_fetch_add(p, v, __ATOMIC_RELAXED, __HIP_MEMORY_SCOPE_AGENT); }
__device__ __forceinline__ unsigned xb_xcc_id() { return (unsigned)__builtin_amdgcn_s_getreg((3 << 11) | 20) & 0xFu; }
#define XB_SPIN(cond, bar) do { unsigned _sp = 0; while (cond) { __builtin_amdgcn_s_sleep(1); \
    if ((++_sp & 255u) == 0u) { if (xb_ld(&(bar)[XB_TMO])) break; if (_sp > XB_SPIN_CAP) { atomicAdd(&(bar)[XB_TMO], 1u); break; } } } } while (0)
struct XcdBarrier { unsigned* bar; unsigned x; volatile LAS unsigned* st; };
__device__ __forceinline__ XcdBarrier xcd_barrier_post(unsigned* bar, volatile LAS unsigned* st) {
    XcdBarrier b; b.bar = bar; b.x = xb_xcc_id(); b.st = st;
    if (threadIdx.x == 0) (void)xb_add(&bar[XB_XCNT(b.x)], 1u);
    return b;
}
__device__ __forceinline__ void xcd_barrier_complete(unsigned* bar, unsigned x, unsigned& nloc, unsigned& nx) {
    const unsigned G = gridDim.x * gridDim.y * gridDim.z;
    unsigned sum, cnt, mine, sp = 0u;
    for (;;) {
        sum = 0u; cnt = 0u; mine = 0u;
#pragma unroll
        for (unsigned j = 0; j < 16; ++j) { const unsigned c = xb_ld(&bar[XB_XCNT(j)]); sum += c; cnt += (c > 0u) ? 1u : 0u; mine = (j == x) ? c : mine; }
        if (sum == G) break;
        __builtin_amdgcn_s_sleep(1);
        if ((++sp & 255u) == 0u) { if (xb_ld(&bar[XB_TMO])) break; if (sp > XB_SPIN_CAP) { atomicAdd(&bar[XB_TMO], 1u); break; } }
    }
    nloc = mine > 0u ? mine : 1u; nx = cnt > 0u ? cnt : 1u;
}
__device__ __forceinline__ void xcd_barrier(const XcdBarrier& b) {
    asm volatile("s_waitcnt vmcnt(0)" ::: "memory");
    __syncthreads();
    if (threadIdx.x == 0) {
        unsigned* bar = b.bar;
        __builtin_amdgcn_s_waitcnt(0);
        unsigned nloc = b.st[0], nx = b.st[1];
        if (nloc == 0u) { xcd_barrier_complete(bar, b.x, nloc, nx); b.st[0] = nloc; b.st[1] = nx; }
        const unsigned old = xb_add(&bar[XB_XSUB(b.x)], 1u);
        const unsigned gen = old / nloc;
        if (old + 1u == (gen + 1u) * nloc) {
            __builtin_amdgcn_fence(__ATOMIC_RELEASE, "agent");
            asm volatile("s_waitcnt vmcnt(0)" ::: "memory");
            const unsigned og = xb_add(&bar[XB_TOP], 1u);
            const unsigned tg = og / nx;
            if (og + 1u == (tg + 1u) * nx) xb_add(&bar[XB_TOPGEN], 1u);
            else XB_SPIN(xb_ld(&bar[XB_TOPGEN]) == tg, bar);
            __builtin_amdgcn_fence(__ATOMIC_ACQUIRE, "agent");
            xb_add(&bar[XB_XGEN(b.x)], 1u);
            asm volatile("s_waitcnt vmcnt(0)" ::: "memory");
        } else {
            XB_SPIN(xb_ld(&bar[XB_XGEN(b.x)]) == gen, bar);
            __builtin_amdgcn_fence(__ATOMIC_ACQUIRE, "agent");
            asm volatile("s_waitcnt vmcnt(0)" ::: "memory");
        }
    }
    __syncthreads();
}

__device__ __forceinline__ void group_barrier(unsigned* word, unsigned n) {
    asm volatile("s_waitcnt vmcnt(0)" ::: "memory");
    __syncthreads();
    if (threadIdx.x == 0) {
        __builtin_amdgcn_fence(__ATOMIC_RELEASE, "agent");
        asm volatile("s_waitcnt vmcnt(0)" ::: "memory");
        (void)xb_add(word, 1u);
        unsigned sp = 0u; while (xb_ld(word) < n) { __builtin_amdgcn_s_sleep(1); if (++sp > (1u << 22)) break; }
        __builtin_amdgcn_fence(__ATOMIC_ACQUIRE, "agent");
        asm volatile("s_waitcnt vmcnt(0)" ::: "memory");
    }
    __syncthreads();
}

__global__ __launch_bounds__(512, 2) void fwd_kernel(Args a) {
    extern __shared__ __attribute__((aligned(16))) unsigned char shm[];
    LAS unsigned char* lds = (LAS unsigned char*)shm;
    cg::grid_group grid = cg::this_grid();
    unsigned char* ws = a.ws;
    bf16_t* W1in = (bf16_t*)(ws + OFF_W1IN); bf16_t* W1out = (bf16_t*)(ws + OFF_W1OUT); bf16_t* Wmix = (bf16_t*)(ws + OFF_WMIX);
    bf16_t* Who = (bf16_t*)(ws + OFF_WHO); bf16_t* Wco = (bf16_t*)(ws + OFF_WCO); bf16_t* Wmo = (bf16_t*)(ws + OFF_WMO);
    bf16_t* W2in = (bf16_t*)(ws + OFF_W2IN); bf16_t* W2out = (bf16_t*)(ws + OFF_W2OUT);
    float* mod = (float*)(ws + OFF_MOD); float* oml = (float*)(ws + OFF_LB);
    bf16_t* hbuf = (bf16_t*)(ws + OFF_HBUF); bf16_t* act = (bf16_t*)(ws + OFF_R); bf16_t* P = (bf16_t*)(ws + OFF_R);
    bf16_t* slot0 = P, *slot1 = P + SLOT / 2, *slot2 = P + 2 * (SLOT / 2), *slot3 = P + 3 * (SLOT / 2), *slot4 = P + 4 * (SLOT / 2);
    const float* x = a.in[0]; float* xres = a.out; bf16_t* xs = (bf16_t*)(ws + OFF_XRES);
    bf16_t* dsl0 = (bf16_t*)a.out; bf16_t* dsl1 = dsl0 + SLOT / 2;
    LAS unsigned* xbst = (LAS unsigned*)(lds + LDS_MAIN);
    XcdBarrier xb; xb.bar = (unsigned*)(ws + OFF_BAR); xb.x = 0; xb.st = (volatile LAS unsigned*)xbst;
    if (a.coop) {
        if (threadIdx.x == 0) { xbst[0] = 0u; xbst[1] = 0u; xbst[2] = 0u; xbst[3] = 0u; }
        __syncthreads();
        xb = xcd_barrier_post((unsigned*)(ws + OFF_BAR), (volatile LAS unsigned*)xbst);
        grid.sync();
    }
#define PHASE(p) if (a.ph_lo <= (p) && (p) < a.ph_hi)
#define SYNC(p) do { if (a.coop && a.ph_lo <= (p) && (p) + 1 < a.ph_hi) { xcd_barrier(xb); } } while (0)
    PHASE(0) for (int rep = 0; rep < (DUP_PHASE == 0 ? 2 : 1); ++rep) {
        mod_phase(lds, a.in[1], a.in[2], a.in[3], a.in[9], mod, oml);
        const bool defer = (gridDim.x == 256) && a.coop;
        const int wf = (int)blockIdx.x, wst = (int)gridDim.x;
        conv_weight(lds, a.in[5], W1in, DM, 2 * DFF, 1, wf, wst);
        conv_weight(lds, a.in[6], W1out, DFF, DM, 0, wf, wst);
        conv_weight(lds, a.in[8], Wmix, DM, 8192, 2, wf, wst);
        conv_weight(lds, a.in[16], Wco, DM, DM, 0, wf, wst);
        if (!defer) {
            conv_weight(lds, a.in[11], Who, DM, DM, 0, wf, wst);
            conv_weight(lds, a.in[17], Wmo, DM, DM, 0, wf, wst);
            conv_weight(lds, a.in[19], W2in, DM, 2 * DFF, 1, wf, wst);
            conv_weight(lds, a.in[20], W2out, DFF, DM, 0, wf, wst);
        }
    }
    SYNC(0);
    PHASE(1) for (int rep = 0; rep < (DUP_PHASE == 1 ? 2 : 1); ++rep) norm_mod_phase(x, a.in[4], mod, 0, hbuf);
    SYNC(1);
    PHASE(2) for (int rep = 0; rep < (DUP_PHASE == 2 ? 2 : 1); ++rep) { pg8::Gemm g{hbuf, W1in, MTOK, 2 * DFF, DM}; EpiSwiGLU E{act, DFF}; pg8::gemm_phase(lds, g, E); }
    SYNC(2);
    PHASE(3) for (int rep = 0; rep < (DUP_PHASE == 3 ? 2 : 1); ++rep) { pg8::Gemm g{act, W1out, MTOK, DM, DFF}; EpiResidB<1, 1> E{x, xs, mod + 2 * DM}; pg8::gemm_phase(lds, g, E); }
    SYNC(3);
    PHASE(4) norm_mod_phase_b(xs, a.in[7], mod, 3, hbuf);
    SYNC(4);
    PHASE(5) { pg8::Gemm g{hbuf, Wmix, MTOK, 4096, DM}; EpiMixA E{P, oml}; pg8::gemm_phase(lds, g, E); }
    SYNC(5);
    const bool split = (gridDim.x == 256) && a.coop;
    const int sl_ = blockIdx.x >> 3, xc_ = blockIdx.x & 7; const bool scan_wg = split && ((sl_ & 3) == 0);
    const int pidx = (sl_ - (sl_ >> 2) - 1) * 8 + xc_;
    PHASE(6) {
        pg8::Gemm g{hbuf, Wmix + (size_t)4096 * DM, MTOK, 4096, DM}; EpiMixB E{slot4, dsl0, dsl1};
        const int hfirst = split ? (scan_wg ? (sl_ >> 2) * 8 + xc_ : 64) : (int)blockIdx.x, hstep = split ? 64 : (int)gridDim.x;
        for (int bh = hfirst; bh < 64; bh += hstep) hgrn_unit(lds, bh, slot0, slot1, slot2, slot3, a.in[10]);
        if (!scan_wg) {
            const pg8::Split sp = split ? pg8::Split{192, pidx, 0, 11} : pg8::Split{(int)gridDim.x, (int)blockIdx.x, 0, 1 << 30};
            pg8::gemm_phase(lds, g, E, sp);
            if (split && pidx >= 128) conv_weight(lds, a.in[19], W2in, DM, 2 * DFF, 1, pidx - 128, 64);
            if (split) group_barrier((unsigned*)(ws + OFF_BAR) + 64, 192u);
        }
    }
    if (!split) SYNC(6);
    PHASE(7) conv_phase(lds, slot4, a.in[12], a.in[13], a.in[14], a.in[15], hbuf, split ? (scan_wg ? MTOK : pidx) : (int)blockIdx.x, split ? 192 : (int)gridDim.x);
    if (!split) SYNC(7);
    PHASE(8) {
        if (split && !scan_wg) group_barrier((unsigned*)(ws + OFF_BAR) + 96, 192u);
        if (!scan_wg) { pg8::Gemm g{hbuf, Wco, MTOK, DM, DM}; EpiGate<0> E{dsl1, nullptr};
            const pg8::Split sp = split ? pg8::Split{192, pidx, 0, 3} : pg8::Split{(int)gridDim.x, (int)blockIdx.x, 0, 1 << 30};
            pg8::gemm_phase(lds, g, E, sp);
            if (split && pidx >= 128) {
                conv_weight(lds, a.in[20], W2out, DFF, DM, 0, pidx - 128, 64);
                conv_weight(lds, a.in[11], Who, DM, DM, 0, pidx - 128, 64);
                conv_weight(lds, a.in[17], Wmo, DM, DM, 0, pidx - 128, 64);
            } }
    }
    SYNC(8);
    PHASE(9) { pg8::Gemm g{slot2, Who, MTOK, DM, DM}; EpiGate<1> E{dsl0, dsl1}; pg8::gemm_phase(lds, g, E); }
    SYNC(9);
    PHASE(10) { pg8::Gemm g{dsl0, Wmo, MTOK, DM, DM}; EpiResidB<0, 0> E{x, xs, mod + 5 * DM}; pg8::gemm_phase(lds, g, E); }
    SYNC(10);
    PHASE(11) norm_mod_phase_b(xs, a.in[18], mod, 6, hbuf);
    SYNC(11);
    PHASE(12) { pg8::Gemm g{hbuf, W2in, MTOK, 2 * DFF, DM}; EpiSwiGLU E{act, DFF}; pg8::gemm_phase(lds, g, E); }
    SYNC(12);
    PHASE(13) { pg8::Gemm g{act, W2out, MTOK, DM, DFF}; EpiStore E{hbuf}; pg8::gemm_phase(lds, g, E); }
    SYNC(13);
    PHASE(14) final_norm_phase_b(xs, hbuf, mod + 8 * DM, 0.5f, a.in[21], xres);
#if DBG_DUMP >= 0
    PHASE(15) { const bf16_t* src = DBG_DUMP == 5 ? hbuf : P + (size_t)DBG_DUMP * (SLOT / 2);
        for (size_t i = (size_t)blockIdx.x * 512 + threadIdx.x; i < (size_t)MTOK * DM; i += (size_t)gridDim.x * 512) { const float v = bf2f(src[i]); xres[i] = (v - v == 0.f) ? v : 10000.f; } }
#endif
#undef PHASE
#undef SYNC
}
constexpr int NPHASE = 15;

extern "C" void kernel_launch(void* const* d_in, const int* in_sizes, int n_in, void* d_out, int out_size, void* d_ws, size_t ws_size, hipStream_t stream) {
    static int grid = 0;
    if (grid == 0) {
        if (n_in != 22 || out_size != MTOK * DM || ws_size < WS_NEED) { fprintf(stderr, "kernel_launch: unexpected shapes: n_in %d out %d ws %zu (need %zu)\n", n_in, out_size, ws_size, (size_t)WS_NEED); grid = -1; return; }
        int dev = 0, cus = 0, per_cu = 0;
        hipGetDevice(&dev);
        hipDeviceGetAttribute(&cus, hipDeviceAttributeMultiprocessorCount, dev);
        if (hipFuncSetAttribute((const void*)fwd_kernel, hipFuncAttributeMaxDynamicSharedMemorySize, LDS_BYTES) != hipSuccess) { fprintf(stderr, "kernel_launch: hipFuncSetAttribute failed\n"); grid = -1; return; }
        if (hipOccupancyMaxActiveBlocksPerMultiprocessor(&per_cu, (const void*)fwd_kernel, 512, LDS_BYTES) != hipSuccess || per_cu < 1) { fprintf(stderr, "kernel_launch: occupancy query says %d\n", per_cu); per_cu = 1; }
        (void)hipGetLastError();
        grid = cus * 1;
        if (grid > 256) grid = 256;
        fprintf(stderr, "kernel_launch: grid %d (cus %d, per_cu %d)\n", grid, cus, per_cu);
    }
    if (grid < 0) return;
    Args a{};
    for (int i = 0; i < 22; ++i) a.in[i] = (const float*)d_in[i];
    a.out = (float*)d_out; a.ws = (unsigned char*)d_ws;
#if ONE_LAUNCH
    (void)hipMemsetAsync((unsigned char*)d_ws + OFF_BAR, 0, XCD_BAR_WORDS * sizeof(unsigned), stream);
    a.ph_lo = 0; a.ph_hi = NPHASE; a.coop = 1;
    void* args[] = {&a};
    hipError_t e = hipLaunchCooperativeKernel((const void*)fwd_kernel, dim3(grid), dim3(512), args, LDS_BYTES, stream);
    if (e != hipSuccess) fprintf(stderr, "cooperative launch failed: %s (grid %d)\n", hipGetErrorString(e), grid);
#else
    for (int p = 0; p < 16; ++p) {
        if (p >= DBG_STOP && p != 15) continue;
        if (p == 15 && DBG_DUMP < 0) continue;
        a.ph_lo = p; a.ph_hi = p + 1; a.coop = 0;
        hipLaunchKernelGGL(fwd_kernel, dim3(grid), dim3(512), LDS_BYTES, stream, a);
    }
#endif
}
```

```cpp
#include <hip/hip_runtime.h>
#include <hip/hip_cooperative_groups.h>
#include <cstdio>
namespace cg = cooperative_groups;

#ifndef ONE_LAUNCH
#define ONE_LAUNCH 1
#endif
#ifndef DUP_PHASE
#define DUP_PHASE -1
#endif
#ifndef DBG_STOP
#define DBG_STOP 15
#endif
#ifndef DBG_DUMP
#define DBG_DUMP -1
#endif

#define LAS __attribute__((address_space(3)))
typedef unsigned short bf16_t;
typedef short bf16x8 __attribute__((ext_vector_type(8)));
typedef float f32x4 __attribute__((ext_vector_type(4)));
typedef float f32x2 __attribute__((ext_vector_type(2)));
typedef unsigned u32x4 __attribute__((ext_vector_type(4)));
typedef unsigned u32x2 __attribute__((ext_vector_type(2)));

constexpr int MTOK = 32768, DM = 1024, SEQ = 4096, DFF = 2816, NMOD = 9;
constexpr float EPS = 1e-6f;
constexpr int LDS_MAIN = 135168;
constexpr int LDS_BYTES = LDS_MAIN + 16;

constexpr size_t MiB = 1ull << 20;
constexpr size_t OFF_W1IN = 0;
constexpr size_t OFF_W1OUT = OFF_W1IN + 5632ull * 1024 * 2;
constexpr size_t OFF_WMIX = OFF_W1OUT + 1024ull * 2816 * 2;
constexpr size_t OFF_WHO = OFF_WMIX + 8192ull * 1024 * 2;
constexpr size_t OFF_WCO = OFF_WHO + 2 * MiB;
constexpr size_t OFF_WMO = OFF_WCO + 2 * MiB;
constexpr size_t OFF_W2IN = OFF_WMO + 2 * MiB;
constexpr size_t OFF_W2OUT = OFF_W2IN + 5632ull * 1024 * 2;
constexpr size_t OFF_MOD = 55 * MiB;
constexpr size_t OFF_LB = OFF_MOD + 512 * 1024;
constexpr size_t OFF_BAR = OFF_MOD + 768 * 1024;
constexpr size_t OFF_HBUF = 56 * MiB;
constexpr size_t OFF_R = 120 * MiB;
constexpr size_t SLOT = 64 * MiB;
constexpr size_t OFF_XRES = OFF_R + 5 * SLOT;
constexpr size_t WS_NEED = OFF_XRES + 64 * MiB;
static_assert(OFF_W2OUT + 1024ull * 2816 * 2 <= OFF_MOD, "weights overflow");

struct Args {
    const float* in[22];
    float* out;
    unsigned char* ws;
    int ph_lo, ph_hi;
    int coop, pad;
};

typedef __bf16 bf16x2_t __attribute__((ext_vector_type(2)));
__device__ __forceinline__ unsigned cvt_pk_bf16(float lo, float hi) { const f32x2 v = {lo, hi}; return __builtin_bit_cast(unsigned, __builtin_convertvector(v, bf16x2_t)); }
__device__ __forceinline__ bf16_t f2bf(float f) { return (bf16_t)(cvt_pk_bf16(f, 0.f) & 0xffffu); }
__device__ __forceinline__ float bf2f(bf16_t b) { return __uint_as_float(((unsigned)b) << 16); }
__device__ __forceinline__ float bflo(unsigned w) { return __uint_as_float(w << 16); }
__device__ __forceinline__ float bfhi(unsigned w) { return __uint_as_float(w & 0xffff0000u); }
__device__ __forceinline__ float fsigmoid(float x) { return __builtin_amdgcn_rcpf(1.0f + __expf(-x)); }
__device__ __forceinline__ float fsilu(float x) { return x * fsigmoid(x); }
__device__ __forceinline__ u32x4 pack8(const f32x4& a, const f32x4& b) {
    u32x4 w; w.x = cvt_pk_bf16(a[0], a[1]); w.y = cvt_pk_bf16(a[2], a[3]); w.z = cvt_pk_bf16(b[0], b[1]); w.w = cvt_pk_bf16(b[2], b[3]); return w;
}
__device__ __forceinline__ void unpack8(const u32x4& w, f32x4& a, f32x4& b) {
    a[0] = bflo(w.x); a[1] = bfhi(w.x); a[2] = bflo(w.y); a[3] = bfhi(w.y);
    b[0] = bflo(w.z); b[1] = bfhi(w.z); b[2] = bflo(w.w); b[3] = bfhi(w.w);
}

namespace pg8 {
constexpr int BM = 256, BK = 64, HALF = 128, HTB = HALF * BK * 2, STAGE_BYTES = 8 * HTB, NXCD = 8, WGM = 4;
__device__ __forceinline__ int lds_byte(int r, int c) { const int st = (r >> 4) * 2 + (c >> 5), rr = r & 15, cc = c & 31, ob = rr * 64 + cc * 2; return st * 1024 + (ob ^ (((ob >> 9) & 1) << 5)); }
__device__ __forceinline__ void stage_rc(int b, int& R, int& C) { const int st = b / 1024, sb = b % 1024, swz = sb ^ (((sb >> 9) & 1) << 5); R = (st >> 1) * 16 + swz / 64; C = (st & 1) * 32 + (swz % 64) / 2; }
__device__ __forceinline__ int perm32(int rho) { const int n = rho >> 4, i = rho & 15; return 8 * (i >> 2) + 4 * n + (i & 3); }
struct Unit { int pm, pn; };
struct Gemm { const bf16_t* A; const bf16_t* Bt; int M, N, K; };
struct StaticOrder {
    int nM, nN, nwg, G, c, base, cnt;
    __device__ void init(int M, int N, int G_, int c_, int base_, int cnt_) { nM = M / BM; nN = N / BM; nwg = nM * nN; G = G_; c = c_; base = base_; cnt = cnt_; }
    __device__ bool next(int i, Unit& u) const {
        if (i >= cnt) return false;
        const long L = (long)base + (long)i * G + c; if (L >= nwg) return false;
        int wgid = (int)L; { const int q = nwg / NXCD, r = nwg % NXCD, xcd = wgid % NXCD, off = wgid / NXCD; wgid = (xcd < r ? xcd * (q + 1) : r * (q + 1) + (xcd - r) * q) + off; }
        const int nig = WGM * nN, gid = wgid / nig, fm = gid * WGM, gsz = (nM - fm) < WGM ? (nM - fm) : WGM;
        u.pm = fm + ((wgid % nig) % gsz); u.pn = (wgid % nig) / gsz; return true;
    }
};

struct Split { int G, c, base, cnt; };
template <class Epi>
__device__ __forceinline__ void gemm_phase(LAS unsigned char* lds, const Gemm g, const Epi E, const Split sp) {
    const int tid = threadIdx.x, wid = __builtin_amdgcn_readfirstlane(tid >> 6), lane = tid & 63, wr = wid >> 2, wc = wid & 3, fr = lane & 15, fq = lane >> 4;
    const int K = g.K, nt = K / BK;
    StaticOrder S; S.init(g.M, g.N, sp.G, sp.c, sp.base, sp.cnt);
    unsigned voffA[2], voffB[2];
#pragma unroll
    for (int i = 0; i < 2; ++i) { int R, C; stage_rc(tid * 16 + i * 8192, R, C); const int Rb = Epi::PERM ? ((R & ~31) + perm32(R & 31)) : R;
        voffA[i] = (unsigned)(R * K + C) * 2u; voffB[i] = (unsigned)(Rb * K + C) * 2u; }
    const size_t kstep = (size_t)(BK * 2);
    const size_t hstep = (size_t)HALF * K * 2;
    const size_t tstep = 2 * hstep;
    const unsigned ldsw = (unsigned)wid * 1024u;
    const int aoff = lds_byte(wr * 64 + fr, fq * 8), boff = lds_byte(wc * 32 + fr, fq * 8);
#define PG8_SA(b, h) (((b) * 2 + (h)) * HTB)
#define PG8_SB(b, h) ((4 + (b) * 2 + (h)) * HTB)
#define PG8_STAGE(bufoff, gbase, voff) do { _Pragma("unroll") for (int _i = 0; _i < 2; ++_i) \
        __builtin_amdgcn_global_load_lds((const unsigned*)((const char*)(gbase) + (voff)[_i]), (LAS unsigned*)(lds + (bufoff) + ldsw + _i * 8192), 16, 0, 0); } while (0)
#define PG8_LDA(dst, b, h) do { _Pragma("unroll") for (int m = 0; m < 4; ++m) _Pragma("unroll") for (int k = 0; k < 2; ++k) dst[m][k] = *(const LAS bf16x8*)(lds + PG8_SA(b, h) + aoff + m * 2048 + k * 1024); } while (0)
#define PG8_LDB(dst, b, h) do { _Pragma("unroll") for (int n = 0; n < 2; ++n) _Pragma("unroll") for (int k = 0; k < 2; ++k) dst[n][k] = *(const LAS bf16x8*)(lds + PG8_SB(b, h) + boff + n * 2048 + k * 1024); } while (0)
#define PG8_MMA(ai, bj, At, Bt) do { __builtin_amdgcn_s_setprio(1); _Pragma("unroll") for (int m = 0; m < 4; ++m) _Pragma("unroll") for (int n = 0; n < 2; ++n) _Pragma("unroll") for (int k = 0; k < 2; ++k) \
        acc[ai][bj][m][n] = __builtin_amdgcn_mfma_f32_16x16x32_bf16(Bt[n][k], At[m][k], acc[ai][bj][m][n], 0, 0, 0); __builtin_amdgcn_s_setprio(0); } while (0)
#define PG8_WAIT_V(n) asm volatile("s_waitcnt vmcnt(" #n ")" ::: "memory")
#define PG8_WAIT_L(n) asm volatile("s_waitcnt lgkmcnt(" #n ")" ::: "memory")
#define PG8_BAR __builtin_amdgcn_s_barrier()
#define PG8_SCHED __builtin_amdgcn_sched_barrier(0)
    Unit cur, nxt; int ui = 0;
    if (!S.next(0, cur)) return;
    f32x4 acc[2][2][4][2];
#pragma unroll
    for (int a = 0; a < 2; ++a)
#pragma unroll
        for (int b = 0; b < 2; ++b)
#pragma unroll
            for (int m = 0; m < 4; ++m)
#pragma unroll
                for (int n = 0; n < 2; ++n) acc[a][b][m][n] = (f32x4){0.f, 0.f, 0.f, 0.f};
    bf16x8 At[4][2], B0[2][2], B1[2][2];
    const char* cA = (const char*)g.A + (size_t)cur.pm * tstep; const char* cB = (const char*)g.Bt + (size_t)cur.pn * tstep;
    PG8_STAGE(PG8_SB(0, 0), cB, voffB); PG8_STAGE(PG8_SA(0, 0), cA, voffA); PG8_STAGE(PG8_SB(0, 1), cB + hstep, voffB); PG8_STAGE(PG8_SA(0, 1), cA + hstep, voffA);
    if (wr == 1) PG8_BAR;
    PG8_WAIT_V(4); PG8_BAR;
    PG8_STAGE(PG8_SB(1, 0), cB + kstep, voffB); PG8_STAGE(PG8_SA(1, 0), cA + kstep, voffA); PG8_STAGE(PG8_SB(1, 1), cB + hstep + kstep, voffB);
    PG8_WAIT_V(6); PG8_BAR;
    for (;;) {
        const bool has_next = S.next(ui + 1, nxt);
        const char* nA = has_next ? (const char*)g.A + (size_t)nxt.pm * tstep : cA; const char* nB = has_next ? (const char*)g.Bt + (size_t)nxt.pn * tstep : cB;
        for (int t = 0; t < nt; t += 2) {
            const bool last = (t == nt - 2);
            const char* a1 = cA + (size_t)(t + 1) * kstep;
            const char* a2 = last ? nA : cA + (size_t)(t + 2) * kstep; const char* b2 = last ? nB : cB + (size_t)(t + 2) * kstep;
            const char* a3 = a2 + kstep; const char* b3 = b2 + kstep;
            PG8_LDB(B0, 0, 0); PG8_SCHED; PG8_LDA(At, 0, 0); PG8_STAGE(PG8_SA(1, 1), a1 + hstep, voffA);
            PG8_WAIT_L(8); PG8_BAR; PG8_WAIT_L(0); PG8_MMA(0, 0, At, B0); PG8_BAR; PG8_SCHED;
            PG8_LDB(B1, 0, 1); PG8_STAGE(PG8_SB(0, 0), b2, voffB);
            PG8_BAR; PG8_WAIT_L(0); PG8_MMA(0, 1, At, B1); PG8_BAR;
            PG8_LDA(At, 0, 1); PG8_STAGE(PG8_SA(0, 0), a2, voffA);
            PG8_BAR; PG8_WAIT_L(0); PG8_MMA(1, 0, At, B0); PG8_BAR; PG8_SCHED;
            PG8_STAGE(PG8_SB(0, 1), b2 + hstep, voffB);
            PG8_WAIT_V(6); PG8_BAR; PG8_MMA(1, 1, At, B1); PG8_BAR;
            PG8_LDB(B0, 1, 0); PG8_SCHED; PG8_LDA(At, 1, 0); PG8_STAGE(PG8_SA(0, 1), a2 + hstep, voffA);
            PG8_WAIT_L(8); PG8_BAR; PG8_WAIT_L(0); PG8_MMA(0, 0, At, B0); PG8_BAR; PG8_SCHED;
            PG8_LDB(B1, 1, 1); PG8_STAGE(PG8_SB(1, 0), b3, voffB);
            PG8_BAR; PG8_WAIT_L(0); PG8_MMA(0, 1, At, B1); PG8_BAR;
            PG8_LDA(At, 1, 1); PG8_STAGE(PG8_SA(1, 0), a3, voffA);
            PG8_BAR; PG8_WAIT_L(0); PG8_MMA(1, 0, At, B0); PG8_BAR; PG8_SCHED;
            PG8_STAGE(PG8_SB(1, 1), b3 + hstep, voffB);
            PG8_WAIT_V(6); PG8_BAR; PG8_MMA(1, 1, At, B1); PG8_BAR;
        }
        E(acc, cur, wr, wc, fr, fq);
        if (!has_next) break;
#pragma unroll
        for (int a = 0; a < 2; ++a)
#pragma unroll
            for (int b = 0; b < 2; ++b)
#pragma unroll
                for (int m = 0; m < 4; ++m)
#pragma unroll
                    for (int n = 0; n < 2; ++n) acc[a][b][m][n] = (f32x4){0.f, 0.f, 0.f, 0.f};
        cur = nxt; cA = nA; cB = nB; ++ui;
    }
    PG8_WAIT_V(0);
    if (wr == 0) PG8_BAR;
    PG8_BAR;
#undef PG8_SA
#undef PG8_SB
#undef PG8_STAGE
#undef PG8_LDA
#undef PG8_LDB
#undef PG8_MMA
#undef PG8_WAIT_V
#undef PG8_WAIT_L
#undef PG8_BAR
#undef PG8_SCHED
}
template <class Epi>
__device__ __forceinline__ void gemm_phase(LAS unsigned char* lds, const Gemm g, const Epi E) { gemm_phase(lds, g, E, Split{(int)gridDim.x, (int)blockIdx.x, 0, 1 << 30}); }
}
using pg8::Unit;
typedef f32x4 AccT[2][2][4][2];

struct EpiSwiGLU {
    static constexpr bool PERM = true;
    bf16_t* O; int ldo;
    __device__ __forceinline__ void operator()(const AccT& acc, const Unit& u, int wr, int wc, int fr, int fq) const {
        const int row0 = u.pm * 256 + wr * 64 + fr, col0 = u.pn * 128 + wc * 32 + 8 * fq;
#pragma unroll
        for (int ai = 0; ai < 2; ++ai)
#pragma unroll
            for (int m = 0; m < 4; ++m) {
                f32x4 v0, v1;
#pragma unroll
                for (int j = 0; j < 4; ++j) { v0[j] = fsilu(acc[ai][0][m][0][j]) * acc[ai][1][m][0][j]; v1[j] = fsilu(acc[ai][0][m][1][j]) * acc[ai][1][m][1][j]; }
                *(u32x4*)(O + (size_t)(row0 + ai * 128 + m * 16) * ldo + col0) = pack8(v0, v1);
            }
    }
};
struct EpiResid {
    static constexpr bool PERM = false;
    const float* base; float* out; const float* gate; float scale;
    __device__ __forceinline__ void operator()(const AccT& acc, const Unit& u, int wr, int wc, int fr, int fq) const {
        const int row0 = u.pm * 256 + wr * 64 + fr, col0 = u.pn * 256 + wc * 32 + 4 * fq;
        const float* gp = gate + (size_t)(u.pm >> 4) * (NMOD * DM) + col0;
        f32x4 gv[2][2];
#pragma unroll
        for (int bj = 0; bj < 2; ++bj)
#pragma unroll
            for (int n = 0; n < 2; ++n) gv[bj][n] = *(const f32x4*)(gp + bj * 128 + n * 16) * scale;
#pragma unroll
        for (int ai = 0; ai < 2; ++ai)
#pragma unroll
            for (int m = 0; m < 4; ++m) { const size_t off = (size_t)(row0 + ai * 128 + m * 16) * DM + col0;
#pragma unroll
                for (int bj = 0; bj < 2; ++bj)
#pragma unroll
                    for (int n = 0; n < 2; ++n) { const f32x4 bs = *(const f32x4*)(base + off + bj * 128 + n * 16); *(f32x4*)(out + off + bj * 128 + n * 16) = bs + gv[bj][n] * acc[ai][bj][m][n]; }
            }
    }
};
template <int HALFSTEP, int FIRST> struct EpiResidB {
    static constexpr bool PERM = true;
    static constexpr float scale = HALFSTEP ? 0.5f : 1.0f;
    const float* xin; bf16_t* xs; const float* gate;
    __device__ __forceinline__ void operator()(const AccT& acc, const Unit& u, int wr, int wc, int fr, int fq) const {
        const int row0 = u.pm * 256 + wr * 64 + fr, col0 = u.pn * 256 + wc * 32 + 8 * fq;
        const float* gp = gate + (size_t)(u.pm >> 4) * (NMOD * DM) + col0;
#pragma unroll
        for (int bj = 0; bj < 2; ++bj) {
            const f32x4 g0 = *(const f32x4*)(gp + bj * 128) * scale, g1 = *(const f32x4*)(gp + bj * 128 + 4) * scale;
#pragma unroll
            for (int ai = 0; ai < 2; ++ai)
#pragma unroll
                for (int m = 0; m < 4; ++m) { const size_t off = (size_t)(row0 + ai * 128 + m * 16) * DM + col0 + bj * 128;
                    f32x4 b0, b1;
                    if (FIRST) { b0 = *(const f32x4*)(xin + off); b1 = *(const f32x4*)(xin + off + 4); } else unpack8(*(const u32x4*)(xs + off), b0, b1);
                    *(u32x4*)(xs + off) = pack8(b0 + g0 * acc[ai][bj][m][0], b1 + g1 * acc[ai][bj][m][1]); }
        }
    }
};
struct EpiStore {
    static constexpr bool PERM = true;
    bf16_t* D;
    __device__ __forceinline__ void operator()(const AccT& acc, const Unit& u, int wr, int wc, int fr, int fq) const {
        const int row0 = u.pm * 256 + wr * 64 + fr, col0 = u.pn * 256 + wc * 32 + 8 * fq;
#pragma unroll
        for (int ai = 0; ai < 2; ++ai)
#pragma unroll
            for (int m = 0; m < 4; ++m)
#pragma unroll
                for (int bj = 0; bj < 2; ++bj) *(u32x4*)(D + (size_t)(row0 + ai * 128 + m * 16) * DM + col0 + bj * 128) = pack8(acc[ai][bj][m][0], acc[ai][bj][m][1]);
    }
};
struct EpiMixA {
    static constexpr bool PERM = true;
    bf16_t* P; const float* oml;
    template <int SEC> __device__ __forceinline__ void body(const AccT& acc, const Unit& u, int wr, int wc, int fr, int fq) const {
        const int row0 = u.pm * 256 + wr * 64 + fr, col0 = (u.pn & 3) * 256 + wc * 32 + 8 * fq;
        bf16_t* base = P + (size_t)SEC * (SLOT / 2);
#pragma unroll
        for (int bj = 0; bj < 2; ++bj) {
            f32x4 l0 = (f32x4){0.f, 0.f, 0.f, 0.f}, l1 = l0;
            if (SEC == 1) { l0 = *(const f32x4*)(oml + col0 + bj * 128); l1 = *(const f32x4*)(oml + col0 + bj * 128 + 4); }
#pragma unroll
            for (int ai = 0; ai < 2; ++ai)
#pragma unroll
                for (int m = 0; m < 4; ++m) {
                    f32x4 v0 = acc[ai][bj][m][0], v1 = acc[ai][bj][m][1];
                    if (SEC == 0) {
#pragma unroll
                        for (int j = 0; j < 4; ++j) { v0[j] = fsilu(v0[j]) * 0.08838834764831845f; v1[j] = fsilu(v1[j]) * 0.08838834764831845f; }
                    } else if (SEC == 3) {
#pragma unroll
                        for (int j = 0; j < 4; ++j) { v0[j] = fsilu(v0[j]); v1[j] = fsilu(v1[j]); }
                    } else if (SEC == 1) {
#pragma unroll
                        for (int j = 0; j < 4; ++j) { v0[j] = l0[j] * fsigmoid(-v0[j]); v1[j] = l1[j] * fsigmoid(-v1[j]); }
                    }
                    *(u32x4*)(base + (size_t)(row0 + ai * 128 + m * 16) * DM + col0 + bj * 128) = pack8(v0, v1);
                }
        }
    }
    __device__ __forceinline__ void operator()(const AccT& acc, const Unit& u, int wr, int wc, int fr, int fq) const {
        const int sec = u.pn >> 2;
        if (sec == 0) body<0>(acc, u, wr, wc, fr, fq); else if (sec == 1) body<1>(acc, u, wr, wc, fr, fq); else if (sec == 2) body<2>(acc, u, wr, wc, fr, fq); else body<3>(acc, u, wr, wc, fr, fq);
    }
};
struct EpiMixB {
    static constexpr bool PERM = true;
    bf16_t* ug; bf16_t* sga; bf16_t* sgb;
    __device__ __forceinline__ void operator()(const AccT& acc, const Unit& u, int wr, int wc, int fr, int fq) const {
        const int pn = u.pn; const int row0 = u.pm * 256 + wr * 64 + fr;
        if (pn < 8) {
            const int col0 = pn * 128 + wc * 32 + 8 * fq;
#pragma unroll
            for (int ai = 0; ai < 2; ++ai)
#pragma unroll
                for (int m = 0; m < 4; ++m) {
                    f32x4 v0, v1;
#pragma unroll
                    for (int j = 0; j < 4; ++j) { v0[j] = acc[ai][0][m][0][j] * fsigmoid(acc[ai][1][m][0][j]); v1[j] = acc[ai][0][m][1][j] * fsigmoid(acc[ai][1][m][1][j]); }
                    *(u32x4*)(ug + (size_t)(row0 + ai * 128 + m * 16) * DM + col0) = pack8(v0, v1);
                }
        } else {
            bf16_t* base = pn < 12 ? sga : sgb; const int col0 = (pn & 3) * 256 + wc * 32 + 8 * fq;
#pragma unroll
            for (int ai = 0; ai < 2; ++ai)
#pragma unroll
                for (int m = 0; m < 4; ++m)
#pragma unroll
                    for (int bj = 0; bj < 2; ++bj) {
                        f32x4 v0 = acc[ai][bj][m][0], v1 = acc[ai][bj][m][1];
#pragma unroll
                        for (int j = 0; j < 4; ++j) { v0[j] = fsigmoid(v0[j]); v1[j] = fsigmoid(v1[j]); }
                        *(u32x4*)(base + (size_t)(row0 + ai * 128 + m * 16) * DM + col0 + bj * 128) = pack8(v0, v1);
                    }
        }
    }
};
template <int MODE> struct EpiGate {
    static constexpr bool PERM = true;
    bf16_t* G; const bf16_t* Mprev;
    __device__ __forceinline__ void operator()(const AccT& acc, const Unit& u, int wr, int wc, int fr, int fq) const {
        const int row0 = u.pm * 256 + wr * 64 + fr, col0 = u.pn * 256 + wc * 32 + 8 * fq;
#pragma unroll
        for (int ai = 0; ai < 2; ++ai)
#pragma unroll
            for (int m = 0; m < 4; ++m)
#pragma unroll
                for (int bj = 0; bj < 2; ++bj) {
                    const size_t off = (size_t)(row0 + ai * 128 + m * 16) * DM + col0 + bj * 128;
                    f32x4 g0, g1; unpack8(*(const u32x4*)(G + off), g0, g1);
                    f32x4 v0 = g0 * acc[ai][bj][m][0], v1 = g1 * acc[ai][bj][m][1];
                    if (MODE == 1) { f32x4 p0, p1; unpack8(*(const u32x4*)(Mprev + off), p0, p1); v0 += p0; v1 += p1; }
                    *(u32x4*)(G + off) = pack8(v0, v1);
                }
    }
};

__device__ __forceinline__ int wcol_map(int n, int mode) {
    if (mode == 1) { const int j = n >> 8, r = n & 255; return r < 128 ? 128 * j + r : DFF + 128 * j + (r - 128); }
    if (mode == 2 && n >= 4096 && n < 6144) { const int q = n - 4096, j = q >> 8, r = q & 255; return r < 128 ? 4096 + 128 * j + r : 5120 + 128 * j + (r - 128); }
    return n;
}
__device__ void conv_weight(LAS unsigned char* lds, const float* src, bf16_t* dst, int K, int N, int mode, int first, int step) {
    LAS float* tile = (LAS float*)lds;
    const int tid = threadIdx.x; const int nkt = K >> 6, nnt = N >> 6, ntiles = nkt * nnt;
    const int r = tid >> 4, c4 = (tid & 15) * 4;
    int t = first; f32x4 v0 = (f32x4){0.f, 0.f, 0.f, 0.f}, v1 = v0;
    if (t < ntiles) { const int k0 = (t % nkt) * 64, sc0 = wcol_map((t / nkt) * 64, mode);
        v0 = *(const f32x4*)(src + (size_t)(k0 + r) * N + sc0 + c4); v1 = *(const f32x4*)(src + (size_t)(k0 + r + 32) * N + sc0 + c4); }
    while (t < ntiles) {
        const int k0 = (t % nkt) * 64, n0 = (t / nkt) * 64; const int tn = t + step;
        f32x4 p0 = v0, p1 = v1;
        if (tn < ntiles) { const int kn = (tn % nkt) * 64, scn = wcol_map((tn / nkt) * 64, mode);
            p0 = *(const f32x4*)(src + (size_t)(kn + r) * N + scn + c4); p1 = *(const f32x4*)(src + (size_t)(kn + r + 32) * N + scn + c4); }
        tile[r * 65 + c4 + 0] = v0[0]; tile[r * 65 + c4 + 1] = v0[1]; tile[r * 65 + c4 + 2] = v0[2]; tile[r * 65 + c4 + 3] = v0[3];
        tile[(r + 32) * 65 + c4 + 0] = v1[0]; tile[(r + 32) * 65 + c4 + 1] = v1[1]; tile[(r + 32) * 65 + c4 + 2] = v1[2]; tile[(r + 32) * 65 + c4 + 3] = v1[3];
        __syncthreads();
        { const int n = tid >> 3, k8 = (tid & 7) * 8; f32x4 a, b;
#pragma unroll
          for (int j = 0; j < 4; ++j) { a[j] = tile[(k8 + j) * 65 + n]; b[j] = tile[(k8 + 4 + j) * 65 + n]; }
          *(u32x4*)(dst + (size_t)(n0 + n) * K + k0 + k8) = pack8(a, b); }
        __syncthreads();
        v0 = p0; v1 = p1; t = tn;
    }
}
__device__ void mod_phase(LAS unsigned char* lds, const float* c, const float* ada_w, const float* ada_b, const float* hgrn_lb, float* mod, float* oml) {
    LAS float* cs = (LAS float*)lds;
    LAS float* red = (LAS float*)(lds + 32768);
    const int tid = threadIdx.x;
    constexpr int NT = (NMOD * DM) / 36;
    for (int i = tid; i < 8 * DM; i += 512) cs[i] = fsilu(c[i]);
    __syncthreads();
    for (int task = blockIdx.x; task < NT; task += gridDim.x) {
        const int j0 = task * 36;
        if (tid < 288) {
            const int q = tid % 9, kg = tid / 9;
            f32x4 acc[8];
#pragma unroll
            for (int b = 0; b < 8; ++b) acc[b] = (f32x4){0.f, 0.f, 0.f, 0.f};
            const float* wp = ada_w + (size_t)(kg * 32) * (NMOD * DM) + j0 + 4 * q;
#pragma unroll
            for (int k8 = 0; k8 < 32; k8 += 8) {
                f32x4 w[8];
#pragma unroll
                for (int i = 0; i < 8; ++i) w[i] = *(const f32x4*)(wp + (size_t)(k8 + i) * (NMOD * DM));
#pragma unroll
                for (int b = 0; b < 8; ++b) { const f32x4 c0 = *(const LAS f32x4*)(cs + b * DM + kg * 32 + k8), c1 = *(const LAS f32x4*)(cs + b * DM + kg * 32 + k8 + 4);
                    acc[b] += c0[0] * w[0] + c0[1] * w[1] + c0[2] * w[2] + c0[3] * w[3] + c1[0] * w[4] + c1[1] * w[5] + c1[2] * w[6] + c1[3] * w[7]; }
            }
#pragma unroll
            for (int b = 0; b < 8; ++b) { red[(kg * 8 + b) * 36 + 4 * q + 0] = acc[b][0]; red[(kg * 8 + b) * 36 + 4 * q + 1] = acc[b][1]; red[(kg * 8 + b) * 36 + 4 * q + 2] = acc[b][2]; red[(kg * 8 + b) * 36 + 4 * q + 3] = acc[b][3]; }
        }
        __syncthreads();
        if (tid < 288) { const int b = tid / 36, col = tid % 36; float sacc = ada_b[j0 + col];
#pragma unroll
            for (int g = 0; g < 32; ++g) sacc += red[(g * 8 + b) * 36 + col];
            mod[(size_t)b * (NMOD * DM) + j0 + col] = sacc; }
        __syncthreads();
    }
    if (blockIdx.x == gridDim.x - 1) {
        for (int d = tid; d < DM; d += 512) { const float a0 = hgrn_lb[d], a1 = hgrn_lb[DM + d]; const float lb = 1.0f / (1.0f + expf(a1 - a0)); oml[d] = 1.0f - lb; }
    }
}
__device__ void norm_mod_phase(const float* x, const float* gw, const float* mod, int shidx, bf16_t* h) {
    const int wid = threadIdx.x >> 6, lane = threadIdx.x & 63; const int nw = gridDim.x * 8;
    for (int base = (blockIdx.x * 8 + wid) * 16; base < MTOK; base += nw * 16) {
        const float* mp = mod + (size_t)(base >> 12) * (NMOD * DM) + shidx * DM;
        f32x4 wv[4], sv[4];
#pragma unroll
        for (int i = 0; i < 4; ++i) { const int c = i * 256 + lane * 4; wv[i] = *(const f32x4*)(gw + c) * (*(const f32x4*)(mp + DM + c) + 1.0f); sv[i] = *(const f32x4*)(mp + c); }
        for (int r0 = 0; r0 < 16; r0 += 2) {
            f32x4 v[2][4]; float ss[2];
#pragma unroll
            for (int u = 0; u < 2; ++u)
#pragma unroll
                for (int i = 0; i < 4; ++i) v[u][i] = *(const f32x4*)(x + (size_t)(base + r0 + u) * DM + i * 256 + lane * 4);
#pragma unroll
            for (int u = 0; u < 2; ++u) { float t = 0.f;
#pragma unroll
                for (int i = 0; i < 4; ++i) t += v[u][i][0] * v[u][i][0] + v[u][i][1] * v[u][i][1] + v[u][i][2] * v[u][i][2] + v[u][i][3] * v[u][i][3];
#pragma unroll
                for (int o = 32; o >= 1; o >>= 1) t += __shfl_xor(t, o);
                ss[u] = rsqrtf(t * (1.0f / DM) + EPS); }
#pragma unroll
            for (int u = 0; u < 2; ++u)
#pragma unroll
                for (int i = 0; i < 4; ++i) { const f32x4 y = v[u][i] * ss[u] * wv[i] + sv[i]; u32x2 w; w.x = cvt_pk_bf16(y[0], y[1]); w.y = cvt_pk_bf16(y[2], y[3]);
                    *(u32x2*)(h + (size_t)(base + r0 + u) * DM + i * 256 + lane * 4) = w; }
        }
    }
}
__device__ void norm_mod_phase_b(const bf16_t* x, const float* gw, const float* mod, int shidx, bf16_t* h) {
    const int wid = threadIdx.x >> 6, lane = threadIdx.x & 63; const int nw = gridDim.x * 8;
    for (int base = (blockIdx.x * 8 + wid) * 16; base < MTOK; base += nw * 16) {
        const float* mp = mod + (size_t)(base >> 12) * (NMOD * DM) + shidx * DM;
        f32x4 wv[4], sv[4];
#pragma unroll
        for (int i = 0; i < 4; ++i) { const int c = (i >> 1) * 512 + lane * 8 + (i & 1) * 4; wv[i] = *(const f32x4*)(gw + c) * (*(const f32x4*)(mp + DM + c) + 1.0f); sv[i] = *(const f32x4*)(mp + c); }
        for (int r0 = 0; r0 < 16; r0 += 2) {
            u32x4 raw[2][2]; f32x4 v[2][4]; float ss[2];
#pragma unroll
            for (int u = 0; u < 2; ++u) { const bf16_t* xr = x + (size_t)(base + r0 + u) * DM; raw[u][0] = *(const u32x4*)(xr + lane * 8); raw[u][1] = *(const u32x4*)(xr + 512 + lane * 8); }
#pragma unroll
            for (int u = 0; u < 2; ++u) { unpack8(raw[u][0], v[u][0], v[u][1]); unpack8(raw[u][1], v[u][2], v[u][3]); float t = 0.f;
#pragma unroll
                for (int i = 0; i < 4; ++i) t += v[u][i][0] * v[u][i][0] + v[u][i][1] * v[u][i][1] + v[u][i][2] * v[u][i][2] + v[u][i][3] * v[u][i][3];
#pragma unroll
                for (int o = 32; o >= 1; o >>= 1) t += __shfl_xor(t, o);
                ss[u] = rsqrtf(t * (1.0f / DM) + EPS); }
#pragma unroll
            for (int u = 0; u < 2; ++u) { f32x4 y[4];
#pragma unroll
                for (int i = 0; i < 4; ++i) y[i] = v[u][i] * ss[u] * wv[i] + sv[i];
                bf16_t* hr = h + (size_t)(base + r0 + u) * DM; *(u32x4*)(hr + lane * 8) = pack8(y[0], y[1]); *(u32x4*)(hr + 512 + lane * 8) = pack8(y[2], y[3]); }
        }
    }
}
__device__ void final_norm_phase_b(const bf16_t* x, const bf16_t* D, const float* gate, float scale, const float* gw, float* out) {
    const int wid = threadIdx.x >> 6, lane = threadIdx.x & 63; const int nw = gridDim.x * 8;
    f32x4 gv[4];
#pragma unroll
    for (int i = 0; i < 4; ++i) gv[i] = *(const f32x4*)(gw + (i >> 1) * 512 + lane * 8 + (i & 1) * 4);
    for (int base = (blockIdx.x * 8 + wid) * 16; base < MTOK; base += nw * 16) {
        const float* gp = gate + (size_t)(base >> 12) * (NMOD * DM);
        f32x4 gt[4];
#pragma unroll
        for (int i = 0; i < 4; ++i) gt[i] = *(const f32x4*)(gp + (i >> 1) * 512 + lane * 8 + (i & 1) * 4) * scale;
        for (int r0 = 0; r0 < 16; r0 += 2) {
            u32x4 raw[2][2], rd[2][2]; f32x4 v[2][4]; float ss[2];
#pragma unroll
            for (int u = 0; u < 2; ++u) { const size_t ro = (size_t)(base + r0 + u) * DM; raw[u][0] = *(const u32x4*)(x + ro + lane * 8); raw[u][1] = *(const u32x4*)(x + ro + 512 + lane * 8);
                rd[u][0] = *(const u32x4*)(D + ro + lane * 8); rd[u][1] = *(const u32x4*)(D + ro + 512 + lane * 8); }
#pragma unroll
            for (int u = 0; u < 2; ++u) { f32x4 dv[4]; unpack8(raw[u][0], v[u][0], v[u][1]); unpack8(raw[u][1], v[u][2], v[u][3]); unpack8(rd[u][0], dv[0], dv[1]); unpack8(rd[u][1], dv[2], dv[3]);
                float t = 0.f;
#pragma unroll
                for (int i = 0; i < 4; ++i) { v[u][i] += gt[i] * dv[i]; t += v[u][i][0] * v[u][i][0] + v[u][i][1] * v[u][i][1] + v[u][i][2] * v[u][i][2] + v[u][i][3] * v[u][i][3]; }
#pragma unroll
                for (int o = 32; o >= 1; o >>= 1) t += __shfl_xor(t, o);
                ss[u] = rsqrtf(t * (1.0f / DM) + EPS); }
#pragma unroll
            for (int u = 0; u < 2; ++u)
#pragma unroll
                for (int i = 0; i < 4; ++i) *(f32x4*)(out + (size_t)(base + r0 + u) * DM + (i >> 1) * 512 + lane * 8 + (i & 1) * 4) = v[u][i] * ss[u] * gv[i];
        }
    }
}
__device__ void final_norm_phase(float* x, const float* gw) {
    const int wid = threadIdx.x >> 6, lane = threadIdx.x & 63;
    for (int row = blockIdx.x * 8 + wid; row < MTOK; row += gridDim.x * 8) {
        float* xr = x + (size_t)row * DM; f32x4 v[4]; float ss = 0.f;
#pragma unroll
        for (int i = 0; i < 4; ++i) { v[i] = *(const f32x4*)(xr + i * 256 + lane * 4); ss += v[i][0] * v[i][0] + v[i][1] * v[i][1] + v[i][2] * v[i][2] + v[i][3] * v[i][3]; }
#pragma unroll
        for (int o = 32; o >= 1; o >>= 1) ss += __shfl_xor(ss, o);
        const float r = rsqrtf(ss * (1.0f / DM) + EPS);
#pragma unroll
        for (int i = 0; i < 4; ++i) { const int c = i * 256 + lane * 4; const f32x4 g = *(const f32x4*)(gw + c); *(f32x4*)(xr + c) = v[i] * r * g; }
    }
}
__device__ void conv_phase(LAS unsigned char* lds, const bf16_t* ug, const float* cw, const float* cb, const float* lng, const float* lnb, bf16_t* out, int first, int step) {
    constexpr int T = 32, ROWS = T + 30;
    LAS unsigned* tile = (LAS unsigned*)lds;
    LAS float* wred = (LAS float*)(lds + ROWS * 2048);
    LAS float* stat = (LAS float*)(lds + ROWS * 2048 + 1024);
    const int tid = threadIdx.x, wid = tid >> 6, lane = tid & 63, c0 = tid * 2;
    f32x2 w[31];
#pragma unroll
    for (int j = 0; j < 31; ++j) w[j] = *(const f32x2*)(cw + j * DM + c0);
    const f32x2 bias = *(const f32x2*)(cb + c0), lg = *(const f32x2*)(lng + c0), lb = *(const f32x2*)(lnb + c0);
    for (int blk = first; blk < MTOK / T; blk += step) {
        const int tok0 = blk * T, tseq = tok0 & (SEQ - 1);
#pragma unroll
        for (int k = 0; k < 16; ++k) { const int idx = tid + 512 * k;
            if (idx < ROWS * 128) { const int row = idx >> 7, pc = idx & 127; u32x4 v = (u32x4){0u, 0u, 0u, 0u};
                if (tseq - 30 + row >= 0) v = *(const u32x4*)(ug + (size_t)(tok0 - 30 + row) * DM + pc * 8);
                *(LAS u32x4*)(tile + row * 512 + pc * 4) = v; } }
        __syncthreads();
#pragma unroll 1
        for (int half = 0; half < 2; ++half) {
            const LAS unsigned* trow = tile + (16 * half) * 512 + tid;
            f32x2 acc[16];
#pragma unroll
            for (int t = 0; t < 16; ++t) acc[t] = bias;
#pragma unroll
            for (int i = 0; i < 46; ++i) {
                const unsigned raw = trow[i * 512];
                const f32x2 uv = (f32x2){bflo(raw), bfhi(raw)};
#pragma unroll
                for (int t = 0; t < 16; ++t) { const int j = i - t; if (j >= 0 && j <= 30) acc[t] += w[j] * uv; }
            }
            float v[32];
#pragma unroll
            for (int t = 0; t < 16; ++t) { v[t] = acc[t].x + acc[t].y; v[16 + t] = acc[t].x * acc[t].x + acc[t].y * acc[t].y; }
#pragma unroll
            for (int i = 0; i < 32; ++i) v[i] += __shfl_xor(v[i], 32);
#pragma unroll
            for (int i = 0; i < 16; ++i) { const bool up = (lane & 16) != 0; const float send = up ? v[i] : v[i + 16], keep = up ? v[i + 16] : v[i]; v[i] = keep + __shfl_xor(send, 16); }
#pragma unroll
            for (int i = 0; i < 8; ++i) { const bool up = (lane & 8) != 0; const float send = up ? v[i] : v[i + 8], keep = up ? v[i + 8] : v[i]; v[i] = keep + __shfl_xor(send, 8); }
#pragma unroll
            for (int i = 0; i < 4; ++i) { const bool up = (lane & 4) != 0; const float send = up ? v[i] : v[i + 4], keep = up ? v[i + 4] : v[i]; v[i] = keep + __shfl_xor(send, 4); }
#pragma unroll
            for (int i = 0; i < 2; ++i) { const bool up = (lane & 2) != 0; const float send = up ? v[i] : v[i + 2], keep = up ? v[i + 2] : v[i]; v[i] = keep + __shfl_xor(send, 2); }
            { const bool up = (lane & 1) != 0; const float send = up ? v[0] : v[1], keep = up ? v[1] : v[0]; v[0] = keep + __shfl_xor(send, 1); }
            if (lane < 32) wred[wid * 32 + lane] = v[0];
            __syncthreads();
            if (tid < 16) { float s1 = 0.f, s2 = 0.f;
#pragma unroll
                for (int g = 0; g < 8; ++g) { s1 += wred[g * 32 + tid]; s2 += wred[g * 32 + 16 + tid]; }
                const float mean = s1 * (1.0f / DM); const float var = fmaxf(s2 * (1.0f / DM) - mean * mean, 0.f);
                stat[tid] = mean; stat[16 + tid] = rsqrtf(var + EPS); }
            __syncthreads();
#pragma unroll
            for (int t = 0; t < 16; ++t) { const float mean = stat[t], rs = stat[16 + t];
                const float y0 = (acc[t].x - mean) * rs * lg.x + lb.x, y1 = (acc[t].y - mean) * rs * lg.y + lb.y;
                tile[(16 * half + t) * 512 + tid] = cvt_pk_bf16(fsilu(y0), fsilu(y1)); }
            __syncthreads();
        }
#pragma unroll
        for (int k = 0; k < 8; ++k) { const int idx = tid + 512 * k, row = idx >> 7, pc = idx & 127;
            *(u32x4*)(out + (size_t)(tok0 + row) * DM + pc * 8) = *(const LAS u32x4*)(tile + row * 512 + pc * 4); }
        __syncthreads();
    }
}

constexpr int QS_LD = 136, KT_LD = 72;
constexpr int H_QS = 0, H_KS = H_QS + 64 * QS_LD * 2, H_KT = H_KS + 64 * QS_LD * 2, H_VT = H_KT + 128 * KT_LD * 2, H_ST = H_VT + 128 * KT_LD * 2,
              H_AT = H_ST + 128 * QS_LD * 2, H_EL = H_AT + 64 * KT_LD * 2, H_SSQ = H_EL + 128 * 4, H_OS = H_SSQ + 64 * 2 * 4, H_END = H_OS + 64 * QS_LD * 2;
static_assert(H_END <= LDS_MAIN, "hgrn lds");
template <int N> __device__ __forceinline__ float row_shr_or_one(float x) {
    return __builtin_bit_cast(float, __builtin_amdgcn_update_dpp(0x3f800000, __builtin_bit_cast(int, x), 0x110 + N, 0xf, 0xf, false));
}
__device__ __forceinline__ void hgrn_unit(LAS unsigned char* lds, int bh, const bf16_t* qh, const bf16_t* kk, bf16_t* vo, const bf16_t* sog, const float* hg) {
    LAS bf16_t* Qs = (LAS bf16_t*)(lds + H_QS); LAS bf16_t* Ks = (LAS bf16_t*)(lds + H_KS); LAS bf16_t* KT = (LAS bf16_t*)(lds + H_KT);
    LAS bf16_t* VT = (LAS bf16_t*)(lds + H_VT); LAS bf16_t* ST = (LAS bf16_t*)(lds + H_ST); LAS bf16_t* AT = (LAS bf16_t*)(lds + H_AT);
    LAS float* elast = (LAS float*)(lds + H_EL); LAS float* ssq = (LAS float*)(lds + H_SSQ); LAS bf16_t* Os = (LAS bf16_t*)(lds + H_OS);
    const int tid = threadIdx.x, wid = tid >> 6, lane = tid & 63, fr = lane & 15, fq = lane >> 4;
    const int b = bh >> 3, h = bh & 7; const size_t tokb = (size_t)b * SEQ;
    const int ti = wid >> 1, vh = wid & 1;
    const bf16_t* qp = qh + (tokb + lane) * DM + h * 128 + 16 * wid;
    const bf16_t* kp = kk + (tokb + lane) * DM + h * 128 + 16 * wid;
    const int vs = tid >> 3, v16 = (tid & 7) * 16;
    bf16_t* vp = vo + (tokb + vs) * DM + h * 128 + v16;
    const bf16_t* sp = sog + (tokb + vs) * DM + h * 128 + v16;
    float gq[4];
#pragma unroll
    for (int jj = 0; jj < 4; ++jj) gq[jj] = hg[h * 128 + 64 * vh + 16 * jj + fr];
    for (int i = tid; i < 128 * QS_LD; i += 512) ST[i] = 0;
    f32x4 sacc[8];
#pragma unroll
    for (int vi = 0; vi < 8; ++vi) sacc[vi] = (f32x4){0.f, 0.f, 0.f, 0.f};
    u32x4 kr0 = *(const u32x4*)kp, kr1 = *(const u32x4*)(kp + 8), qr0 = *(const u32x4*)qp, qr1 = *(const u32x4*)(qp + 8);
    u32x4 vr0 = *(const u32x4*)vp, vr1 = *(const u32x4*)(vp + 8);
    __syncthreads();
    for (int c = 0; c < SEQ / 64; ++c) {
        const size_t cadv = (size_t)c * 64 * DM;
        const u32x4 sg0 = *(const u32x4*)(sp + cadv), sg1 = *(const u32x4*)(sp + cadv + 8);
        { f32x4 kf[4], qf[4]; unpack8(kr0, kf[0], kf[1]); unpack8(kr1, kf[2], kf[3]); unpack8(qr0, qf[0], qf[1]); unpack8(qr1, qf[2], qf[3]);
          const int row = lane >> 4;
          unsigned qw[8], kw[8]; f32x4 plast[4];
#pragma unroll
          for (int g4 = 0; g4 < 4; ++g4) {
              f32x4 e4, r4;
#pragma unroll
              for (int j = 0; j < 4; ++j) {
                  float x = 1.0f - kf[g4][j];
                  x *= row_shr_or_one<1>(x); x *= row_shr_or_one<2>(x); x *= row_shr_or_one<4>(x); x *= row_shr_or_one<8>(x);
                  const int xi = __builtin_bit_cast(int, x);
                  const float r0 = __builtin_bit_cast(float, __builtin_amdgcn_readlane(xi, 15)), r1 = __builtin_bit_cast(float, __builtin_amdgcn_readlane(xi, 31)),
                              r2 = __builtin_bit_cast(float, __builtin_amdgcn_readlane(xi, 47)), r3 = __builtin_bit_cast(float, __builtin_amdgcn_readlane(xi, 63));
                  const float m01 = r0 * r1, m012 = m01 * r2;
                  const float mult = row == 0 ? 1.0f : (row == 1 ? r0 : (row == 2 ? m01 : m012));
                  x *= mult;
                  e4[j] = x; r4[j] = __builtin_amdgcn_rcpf(x); plast[g4][j] = m012 * r3; }
              const f32x4 qs = qf[g4] * e4, ks = kf[g4] * r4;
              qw[2 * g4] = cvt_pk_bf16(qs[0], qs[1]); qw[2 * g4 + 1] = cvt_pk_bf16(qs[2], qs[3]);
              kw[2 * g4] = cvt_pk_bf16(ks[0], ks[1]); kw[2 * g4 + 1] = cvt_pk_bf16(ks[2], ks[3]); }
          *(LAS u32x4*)(Qs + lane * QS_LD + 16 * wid) = (u32x4){qw[0], qw[1], qw[2], qw[3]}; *(LAS u32x4*)(Qs + lane * QS_LD + 16 * wid + 8) = (u32x4){qw[4], qw[5], qw[6], qw[7]};
          *(LAS u32x4*)(Ks + lane * QS_LD + 16 * wid) = (u32x4){kw[0], kw[1], kw[2], kw[3]}; *(LAS u32x4*)(Ks + lane * QS_LD + 16 * wid + 8) = (u32x4){kw[4], kw[5], kw[6], kw[7]};
#pragma unroll
          for (int i = 0; i < 8; ++i) { KT[(16 * wid + 2 * i) * KT_LD + lane] = (bf16_t)(kw[i] & 0xffffu); KT[(16 * wid + 2 * i + 1) * KT_LD + lane] = (bf16_t)(kw[i] >> 16); }
          if (lane == 0) {
#pragma unroll
              for (int g4 = 0; g4 < 4; ++g4) *(LAS f32x4*)(elast + 16 * wid + 4 * g4) = plast[g4]; } }
        { VT[(v16 + 0) * KT_LD + vs] = (bf16_t)(vr0.x & 0xffffu); VT[(v16 + 1) * KT_LD + vs] = (bf16_t)(vr0.x >> 16);
          VT[(v16 + 2) * KT_LD + vs] = (bf16_t)(vr0.y & 0xffffu); VT[(v16 + 3) * KT_LD + vs] = (bf16_t)(vr0.y >> 16);
          VT[(v16 + 4) * KT_LD + vs] = (bf16_t)(vr0.z & 0xffffu); VT[(v16 + 5) * KT_LD + vs] = (bf16_t)(vr0.z >> 16);
          VT[(v16 + 6) * KT_LD + vs] = (bf16_t)(vr0.w & 0xffffu); VT[(v16 + 7) * KT_LD + vs] = (bf16_t)(vr0.w >> 16);
          VT[(v16 + 8) * KT_LD + vs] = (bf16_t)(vr1.x & 0xffffu); VT[(v16 + 9) * KT_LD + vs] = (bf16_t)(vr1.x >> 16);
          VT[(v16 + 10) * KT_LD + vs] = (bf16_t)(vr1.y & 0xffffu); VT[(v16 + 11) * KT_LD + vs] = (bf16_t)(vr1.y >> 16);
          VT[(v16 + 12) * KT_LD + vs] = (bf16_t)(vr1.z & 0xffffu); VT[(v16 + 13) * KT_LD + vs] = (bf16_t)(vr1.z >> 16);
          VT[(v16 + 14) * KT_LD + vs] = (bf16_t)(vr1.w & 0xffffu); VT[(v16 + 15) * KT_LD + vs] = (bf16_t)(vr1.w >> 16); }
        if (c + 1 < SEQ / 64) {
            const size_t adv = cadv + (size_t)64 * DM;
            kr0 = *(const u32x4*)(kp + adv); kr1 = *(const u32x4*)(kp + adv + 8); qr0 = *(const u32x4*)(qp + adv); qr1 = *(const u32x4*)(qp + adv + 8);
            vr0 = *(const u32x4*)(vp + adv); vr1 = *(const u32x4*)(vp + adv + 8);
        }
        __syncthreads();
#pragma unroll
        for (int jj = 0; jj < 2; ++jj) {
            const int sj = 2 * (wid & 1) + jj;
            f32x4 a4 = (f32x4){0.f, 0.f, 0.f, 0.f};
            if (sj <= ti) {
#pragma unroll
                for (int kd = 0; kd < 4; ++kd) {
                    const bf16x8 av = *(const LAS bf16x8*)(Qs + (16 * ti + fr) * QS_LD + 32 * kd + 8 * fq);
                    const bf16x8 bv = *(const LAS bf16x8*)(Ks + (16 * sj + fr) * QS_LD + 32 * kd + 8 * fq);
                    a4 = __builtin_amdgcn_mfma_f32_16x16x32_bf16(av, bv, a4, 0, 0, 0);
                }
            }
#pragma unroll
            for (int j = 0; j < 4; ++j) { const int t = 16 * ti + 4 * fq + j, s_ = 16 * sj + fr; AT[t * KT_LD + s_] = (s_ <= t) ? f2bf(a4[j]) : (bf16_t)0; }
        }
        __syncthreads();
        f32x4 o4[4];
        { bf16x8 af[2], qf[4];
#pragma unroll
          for (int ks = 0; ks < 2; ++ks) af[ks] = *(const LAS bf16x8*)(AT + (16 * ti + fr) * KT_LD + 32 * ks + 8 * fq);
#pragma unroll
          for (int kd = 0; kd < 4; ++kd) qf[kd] = *(const LAS bf16x8*)(Qs + (16 * ti + fr) * QS_LD + 32 * kd + 8 * fq);
#pragma unroll
          for (int jj = 0; jj < 4; ++jj) { const int vrow = 64 * vh + 16 * jj + fr; f32x4 t4 = (f32x4){0.f, 0.f, 0.f, 0.f};
#pragma unroll
              for (int ks = 0; ks < 2; ++ks) t4 = __builtin_amdgcn_mfma_f32_16x16x32_bf16(af[ks], *(const LAS bf16x8*)(VT + vrow * KT_LD + 32 * ks + 8 * fq), t4, 0, 0, 0);
#pragma unroll
              for (int kd = 0; kd < 4; ++kd) t4 = __builtin_amdgcn_mfma_f32_16x16x32_bf16(qf[kd], *(const LAS bf16x8*)(ST + vrow * QS_LD + 32 * kd + 8 * fq), t4, 0, 0, 0);
              o4[jj] = t4; } }
#pragma unroll
        for (int j = 0; j < 4; ++j) { float p = (o4[0][j] * o4[0][j] + o4[1][j] * o4[1][j]) + (o4[2][j] * o4[2][j] + o4[3][j] * o4[3][j]);
            p += __shfl_xor(p, 1); p += __shfl_xor(p, 2); p += __shfl_xor(p, 4); p += __shfl_xor(p, 8);
            if (fr == 0) ssq[(16 * ti + 4 * fq + j) * 2 + vh] = p; }
        { bf16x8 kf2[2];
#pragma unroll
          for (int ks = 0; ks < 2; ++ks) kf2[ks] = *(const LAS bf16x8*)(KT + (16 * wid + fr) * KT_LD + 32 * ks + 8 * fq);
          const f32x4 el = *(const LAS f32x4*)(elast + 16 * wid + 4 * fq);
#pragma unroll
          for (int vi = 0; vi < 8; ++vi) {
#pragma unroll
              for (int ks = 0; ks < 2; ++ks) sacc[vi] = __builtin_amdgcn_mfma_f32_16x16x32_bf16(kf2[ks], *(const LAS bf16x8*)(VT + (16 * vi + fr) * KT_LD + 32 * ks + 8 * fq), sacc[vi], 0, 0, 0);
              sacc[vi] = sacc[vi] * el; } }
        __syncthreads();
#pragma unroll
        for (int j = 0; j < 4; ++j) { const int t = 16 * ti + 4 * fq + j; const float r = rsqrtf((ssq[t * 2] + ssq[t * 2 + 1]) * (1.0f / 128.0f) + EPS);
#pragma unroll
            for (int jj = 0; jj < 4; ++jj) Os[t * QS_LD + 64 * vh + 16 * jj + fr] = f2bf(o4[jj][j] * r * gq[jj]); }
#pragma unroll
        for (int vi = 0; vi < 8; ++vi) { u32x2 w; w.x = cvt_pk_bf16(sacc[vi][0], sacc[vi][1]); w.y = cvt_pk_bf16(sacc[vi][2], sacc[vi][3]);
            *(LAS u32x2*)(ST + (16 * vi + fr) * QS_LD + 16 * wid + 4 * fq) = w; }
        __syncthreads();
        { f32x4 ov[4], gv[4]; const u32x4 ow0 = *(const LAS u32x4*)(Os + vs * QS_LD + v16), ow1 = *(const LAS u32x4*)(Os + vs * QS_LD + v16 + 8); unpack8(ow0, ov[0], ov[1]); unpack8(ow1, ov[2], ov[3]);
          unpack8(sg0, gv[0], gv[1]); unpack8(sg1, gv[2], gv[3]);
          *(u32x4*)(vp + cadv) = pack8(ov[0] * gv[0], ov[1] * gv[1]); *(u32x4*)(vp + cadv + 8) = pack8(ov[2] * gv[2], ov[3] * gv[3]); }
    }
    __syncthreads();
}

#define XB_TMO      128
#define XB_XCNT(j)  (256  + 64 * (j))
#define XB_XSUB(j)  (1280 + 64 * (j))
#define XB_XGEN(j)  (2304 + 64 * (j))
#define XB_TOP      3328
#define XB_TOPGEN   3392
#define XCD_BAR_WORDS 3456
#define XB_SPIN_CAP (1u << 18)
__device__ __forceinline__ unsigned xb_ld(unsigned* p)              { return __hip_atomic_load(p, __ATOMIC_RELAXED, __HIP_MEMORY_SCOPE_AGENT); }
__device__ __forceinline__ unsigned xb_add(unsigned* p, unsigned v) { return __hip_atomic_fetch_add(p, v, __ATOMIC_RELAXED, __HIP_MEMORY_SCOPE_AGENT); }
__device__ __forceinline__ unsigned xb_xcc_id() { return (unsigned)__builtin_amdgcn_s_getreg((3 << 11) | 20) & 0xFu; }
#define XB_SPIN(cond, bar) do { unsigned _sp = 0; while (cond) { __builtin_amdgcn_s_sleep(1); \
    if ((++_sp & 255u) == 0u) { if (xb_ld(&(bar)[XB_TMO])) break; if (_sp > XB_SPIN_CAP) { atomicAdd(&(bar)[XB_TMO], 1u); break; } } } } while (0)
struct XcdBarrier { unsigned* bar; unsigned x; volatile LAS unsigned* st; unsigned total; };
__device__ __forceinline__ XcdBarrier xcd_barrier_post(unsigned* bar, volatile LAS unsigned* st) {
    XcdBarrier b; b.bar = bar; b.x = xb_xcc_id(); b.st = st; b.total = gridDim.x * gridDim.y * gridDim.z;
    if (threadIdx.x == 0) (void)xb_add(&bar[XB_XCNT(b.x)], 1u);
    return b;
}
__device__ __forceinline__ void xcd_barrier_complete(unsigned* bar, unsigned x, unsigned& nloc, unsigned& nx, unsigned G) {
    unsigned sum, cnt, mine, sp = 0u;
    for (;;) {
        sum = 0u; cnt = 0u; mine = 0u;
#pragma unroll
        for (unsigned j = 0; j < 16; ++j) { const unsigned c = xb_ld(&bar[XB_XCNT(j)]); sum += c; cnt += (c > 0u) ? 1u : 0u; mine = (j == x) ? c : mine; }
        if (sum == G) break;
        __builtin_amdgcn_s_sleep(1);
        if ((++sp & 255u) == 0u) { if (xb_ld(&bar[XB_TMO])) break; if (sp > XB_SPIN_CAP) { atomicAdd(&bar[XB_TMO], 1u); break; } }
    }
    nloc = mine > 0u ? mine : 1u; nx = cnt > 0u ? cnt : 1u;
}
__device__ __forceinline__ void xcd_barrier(const XcdBarrier& b) {
    asm volatile("s_waitcnt vmcnt(0)" ::: "memory");
    __syncthreads();
    if (threadIdx.x == 0) {
        unsigned* bar = b.bar;
        __builtin_amdgcn_s_waitcnt(0);
        unsigned nloc = b.st[0], nx = b.st[1];
        if (nloc == 0u) { xcd_barrier_complete(bar, b.x, nloc, nx, b.total); b.st[0] = nloc; b.st[1] = nx; }
        const unsigned old = xb_add(&bar[XB_XSUB(b.x)], 1u);
        const unsigned gen = old / nloc;
        if (old + 1u == (gen + 1u) * nloc) {
            __builtin_amdgcn_fence(__ATOMIC_RELEASE, "agent");
            asm volatile("s_waitcnt vmcnt(0)" ::: "memory");
            const unsigned og = xb_add(&bar[XB_TOP], 1u);
            const unsigned tg = og / nx;
            if (og + 1u == (tg + 1u) * nx) xb_add(&bar[XB_TOPGEN], 1u);
            else XB_SPIN(xb_ld(&bar[XB_TOPGEN]) == tg, bar);
            __builtin_amdgcn_fence(__ATOMIC_ACQUIRE, "agent");
            xb_add(&bar[XB_XGEN(b.x)], 1u);
            asm volatile("s_waitcnt vmcnt(0)" ::: "memory");
        } else {
            XB_SPIN(xb_ld(&bar[XB_XGEN(b.x)]) == gen, bar);
            __builtin_amdgcn_fence(__ATOMIC_ACQUIRE, "agent");
            asm volatile("s_waitcnt vmcnt(0)" ::: "memory");
        }
    }
    __syncthreads();
}

__device__ __forceinline__ void group_barrier(unsigned* word, unsigned n) {
    asm volatile("s_waitcnt vmcnt(0)" ::: "memory");
    __syncthreads();
    if (threadIdx.x == 0) {
        __builtin_amdgcn_fence(__ATOMIC_RELEASE, "agent");
        asm volatile("s_waitcnt vmcnt(0)" ::: "memory");
        (void)xb_add(word, 1u);
        unsigned sp = 0u; while (xb_ld(word) < n) { __builtin_amdgcn_s_sleep(1); if (++sp > (1u << 22)) break; }
        __builtin_amdgcn_fence(__ATOMIC_ACQUIRE, "agent");
        asm volatile("s_waitcnt vmcnt(0)" ::: "memory");
    }
    __syncthreads();
}

__global__ __launch_bounds__(512, 2) void fwd_kernel(Args a) {
    extern __shared__ __attribute__((aligned(16))) unsigned char shm[];
    LAS unsigned char* lds = (LAS unsigned char*)shm;
    cg::grid_group grid = cg::this_grid();
    unsigned char* ws = a.ws;
    bf16_t* W1in = (bf16_t*)(ws + OFF_W1IN); bf16_t* W1out = (bf16_t*)(ws + OFF_W1OUT); bf16_t* Wmix = (bf16_t*)(ws + OFF_WMIX);
    bf16_t* Who = (bf16_t*)(ws + OFF_WHO); bf16_t* Wco = (bf16_t*)(ws + OFF_WCO); bf16_t* Wmo = (bf16_t*)(ws + OFF_WMO);
    bf16_t* W2in = (bf16_t*)(ws + OFF_W2IN); bf16_t* W2out = (bf16_t*)(ws + OFF_W2OUT);
    float* mod = (float*)(ws + OFF_MOD); float* oml = (float*)(ws + OFF_LB);
    bf16_t* hbuf = (bf16_t*)(ws + OFF_HBUF); bf16_t* act = (bf16_t*)(ws + OFF_R); bf16_t* P = (bf16_t*)(ws + OFF_R);
    bf16_t* slot0 = P, *slot1 = P + SLOT / 2, *slot2 = P + 2 * (SLOT / 2), *slot3 = P + 3 * (SLOT / 2), *slot4 = P + 4 * (SLOT / 2);
    const float* x = a.in[0]; float* xres = a.out; bf16_t* xs = (bf16_t*)(ws + OFF_XRES);
    bf16_t* dsl0 = (bf16_t*)a.out; bf16_t* dsl1 = dsl0 + SLOT / 2;
    LAS unsigned* xbst = (LAS unsigned*)(lds + LDS_MAIN);
    XcdBarrier xb; xb.bar = (unsigned*)(ws + OFF_BAR); xb.x = 0; xb.st = (volatile LAS unsigned*)xbst; xb.total = gridDim.x;
    XcdBarrier xb2 = xb;
    if (a.coop) {
        if (threadIdx.x == 0) { xbst[0] = 0u; xbst[1] = 0u; xbst[2] = 0u; xbst[3] = 0u; }
        __syncthreads();
        xb = xcd_barrier_post((unsigned*)(ws + OFF_BAR), (volatile LAS unsigned*)xbst);
        if (gridDim.x == 256 && ((blockIdx.x >> 3) & 3) != 0) { xb2 = xcd_barrier_post((unsigned*)(ws + OFF_BAR) + 4096, (volatile LAS unsigned*)(xbst + 2)); xb2.total = 192u; }
        grid.sync();
    }
#define PHASE(p) if (a.ph_lo <= (p) && (p) < a.ph_hi)
#define SYNC(p) do { if (a.coop && a.ph_lo <= (p) && (p) + 1 < a.ph_hi) { xcd_barrier(xb); } } while (0)
    PHASE(0) for (int rep = 0; rep < (DUP_PHASE == 0 ? 2 : 1); ++rep) {
        mod_phase(lds, a.in[1], a.in[2], a.in[3], a.in[9], mod, oml);
        const bool defer = (gridDim.x == 256) && a.coop;
        const int wf = (int)blockIdx.x, wst = (int)gridDim.x;
        conv_weight(lds, a.in[5], W1in, DM, 2 * DFF, 1, wf, wst);
        conv_weight(lds, a.in[6], W1out, DFF, DM, 0, wf, wst);
        conv_weight(lds, a.in[8], Wmix, DM, 8192, 2, wf, wst);
        conv_weight(lds, a.in[16], Wco, DM, DM, 0, wf, wst);
        if (!defer) {
            conv_weight(lds, a.in[11], Who, DM, DM, 0, wf, wst);
            conv_weight(lds, a.in[17], Wmo, DM, DM, 0, wf, wst);
            conv_weight(lds, a.in[19], W2in, DM, 2 * DFF, 1, wf, wst);
            conv_weight(lds, a.in[20], W2out, DFF, DM, 0, wf, wst);
        }
    }
    SYNC(0);
    PHASE(1) for (int rep = 0; rep < (DUP_PHASE == 1 ? 2 : 1); ++rep) norm_mod_phase(x, a.in[4], mod, 0, hbuf);
    SYNC(1);
    PHASE(2) for (int rep = 0; rep < (DUP_PHASE == 2 ? 2 : 1); ++rep) { pg8::Gemm g{hbuf, W1in, MTOK, 2 * DFF, DM}; EpiSwiGLU E{act, DFF}; pg8::gemm_phase(lds, g, E); }
    SYNC(2);
    PHASE(3) for (int rep = 0; rep < (DUP_PHASE == 3 ? 2 : 1); ++rep) { pg8::Gemm g{act, W1out, MTOK, DM, DFF}; EpiResidB<1, 1> E{x, xs, mod + 2 * DM}; pg8::gemm_phase(lds, g, E); }
    SYNC(3);
    PHASE(4) norm_mod_phase_b(xs, a.in[7], mod, 3, hbuf);
    SYNC(4);
    PHASE(5) { pg8::Gemm g{hbuf, Wmix, MTOK, 4096, DM}; EpiMixA E{P, oml}; pg8::gemm_phase(lds, g, E); }
    SYNC(5);
    const bool split = (gridDim.x == 256) && a.coop;
    const int sl_ = blockIdx.x >> 3, xc_ = blockIdx.x & 7; const bool scan_wg = split && ((sl_ & 3) == 0);
    const int pidx = (sl_ - (sl_ >> 2) - 1) * 8 + xc_;
    PHASE(6) {
        pg8::Gemm g{hbuf, Wmix + (size_t)4096 * DM, MTOK, 4096, DM}; EpiMixB E{slot4, dsl0, dsl1};
        const int hfirst = split ? (scan_wg ? (sl_ >> 2) * 8 + xc_ : 64) : (int)blockIdx.x, hstep = split ? 64 : (int)gridDim.x;
        for (int bh = hfirst; bh < 64; bh += hstep) hgrn_unit(lds, bh, slot0, slot1, slot2, slot3, a.in[10]);
        if (!scan_wg) {
            const pg8::Split sp = split ? pg8::Split{192, pidx, 0, 11} : pg8::Split{(int)gridDim.x, (int)blockIdx.x, 0, 1 << 30};
            pg8::gemm_phase(lds, g, E, sp);
            if (split && pidx >= 128) conv_weight(lds, a.in[19], W2in, DM, 2 * DFF, 1, pidx - 128, 64);
            if (split) xcd_barrier(xb2);
        }
    }
    if (!split) SYNC(6);
    PHASE(7) conv_phase(lds, slot4, a.in[12], a.in[13], a.in[14], a.in[15], hbuf, split ? (scan_wg ? MTOK : pidx) : (int)blockIdx.x, split ? 192 : (int)gridDim.x);
    if (!split) SYNC(7);
    PHASE(8) {
        if (split && !scan_wg) xcd_barrier(xb2);
        if (!scan_wg) { pg8::Gemm g{hbuf, Wco, MTOK, DM, DM}; EpiGate<0> E{dsl1, nullptr};
            const pg8::Split sp = split ? pg8::Split{192, pidx, 0, 3} : pg8::Split{(int)gridDim.x, (int)blockIdx.x, 0, 1 << 30};
            pg8::gemm_phase(lds, g, E, sp);
            if (split && pidx >= 128) {
                conv_weight(lds, a.in[20], W2out, DFF, DM, 0, pidx - 128, 64);
                conv_weight(lds, a.in[11], Who, DM, DM, 0, pidx - 128, 64);
                conv_weight(lds, a.in[17], Wmo, DM, DM, 0, pidx - 128, 64);
            } }
    }
    SYNC(8);
    PHASE(9) { pg8::Gemm g{slot2, Who, MTOK, DM, DM}; EpiGate<1> E{dsl0, dsl1}; pg8::gemm_phase(lds, g, E); }
    SYNC(9);
    PHASE(10) { pg8::Gemm g{dsl0, Wmo, MTOK, DM, DM}; EpiResidB<0, 0> E{x, xs, mod + 5 * DM}; pg8::gemm_phase(lds, g, E); }
    SYNC(10);
    PHASE(11) norm_mod_phase_b(xs, a.in[18], mod, 6, hbuf);
    SYNC(11);
    PHASE(12) { pg8::Gemm g{hbuf, W2in, MTOK, 2 * DFF, DM}; EpiSwiGLU E{act, DFF}; pg8::gemm_phase(lds, g, E); }
    SYNC(12);
    PHASE(13) { pg8::Gemm g{act, W2out, MTOK, DM, DFF}; EpiStore E{hbuf}; pg8::gemm_phase(lds, g, E); }
    SYNC(13);
    PHASE(14) final_norm_phase_b(xs, hbuf, mod + 8 * DM, 0.5f, a.in[21], xres);
#if DBG_DUMP >= 0
    PHASE(15) { const bf16_t* src = DBG_DUMP == 5 ? hbuf : P + (size_t)DBG_DUMP * (SLOT / 2);
        for (size_t i = (size_t)blockIdx.x * 512 + threadIdx.x; i < (size_t)MTOK * DM; i += (size_t)gridDim.x * 512) { const float v = bf2f(src[i]); xres[i] = (v - v == 0.f) ? v : 10000.f; } }
#endif
#undef PHASE
#undef SYNC
}
constexpr int NPHASE = 15;

extern "C" void kernel_launch(void* const* d_in, const int* in_sizes, int n_in, void* d_out, int out_size, void* d_ws, size_t ws_size, hipStream_t stream) {
    static int grid = 0;
    if (grid == 0) {
        if (n_in != 22 || out_size != MTOK * DM || ws_size < WS_NEED) { fprintf(stderr, "kernel_launch: unexpected shapes: n_in %d out %d ws %zu (need %zu)\n", n_in, out_size, ws_size, (size_t)WS_NEED); grid = -1; return; }
        int dev = 0, cus = 0, per_cu = 0;
        hipGetDevice(&dev);
        hipDeviceGetAttribute(&cus, hipDeviceAttributeMultiprocessorCount, dev);
        if (hipFuncSetAttribute((const void*)fwd_kernel, hipFuncAttributeMaxDynamicSharedMemorySize, LDS_BYTES) != hipSuccess) { fprintf(stderr, "kernel_launch: hipFuncSetAttribute failed\n"); grid = -1; return; }
        if (hipOccupancyMaxActiveBlocksPerMultiprocessor(&per_cu, (const void*)fwd_kernel, 512, LDS_BYTES) != hipSuccess || per_cu < 1) { fprintf(stderr, "kernel_launch: occupancy query says %d\n", per_cu); per_cu = 1; }
        (void)hipGetLastError();
        grid = cus * 1;
        if (grid > 256) grid = 256;
        fprintf(stderr, "kernel_launch: grid %d (cus %d, per_cu %d)\n", grid, cus, per_cu);
    }
    if (grid < 0) return;
    Args a{};
    for (int i = 0; i < 22; ++i) a.in[i] = (const float*)d_in[i];
    a.out = (float*)d_out; a.ws = (unsigned char*)d_ws;
#if ONE_LAUNCH
    (void)hipMemsetAsync((unsigned char*)d_ws + OFF_BAR, 0, 32768, stream);
    a.ph_lo = 0; a.ph_hi = NPHASE; a.coop = 1;
    void* args[] = {&a};
    hipError_t e = hipLaunchCooperativeKernel((const void*)fwd_kernel, dim3(grid), dim3(512), args, LDS_BYTES, stream);
    if (e != hipSuccess) fprintf(stderr, "cooperative launch failed: %s (grid %d)\n", hipGetErrorString(e), grid);
#else
    for (int p = 0; p < 16; ++p) {
        if (p >= DBG_STOP && p != 15) continue;
        if (p == 15 && DBG_DUMP < 0) continue;
        a.ph_lo = p; a.ph_hi = p + 1; a.coop = 0;
        hipLaunchKernelGGL(fwd_kernel, dim3(grid), dim3(512), LDS_BYTES, stream, a);
    }
#endif
}
```
